# Optimizing an MI355X kernel written in HIP

```python
import jax, jax.numpy as jnp
from jax import lax
import numpy as np

D_MODEL = 1024
BATCH = 16
SEQ = 4096
DEPTH = 1

MEM_LEN = 256
CONV_CH = 512
CONV_GROUPS = 8
CONV_WIDTH = 3
MOBA_HEADS = 8
MOBA_HEAD_DIM = 64
MOBA_WIDTH = MOBA_HEADS * MOBA_HEAD_DIM
MOBA_BLOCK = 256
MOBA_TOPK = 3
MOBA_QCHUNK = 16
MEM_HEADS = 4
MEM_HEAD_DIM = 128
MEM_WIDTH = MEM_HEADS * MEM_HEAD_DIM
N_BRANCH = 3
IN_SPLITS = [CONV_CH, CONV_CH, CONV_CH, MOBA_WIDTH, MOBA_WIDTH, MOBA_WIDTH, MEM_WIDTH,
             D_MODEL, D_MODEL, D_MODEL]
IN_COLS = sum(IN_SPLITS)
D_FF = 2816
FFN_CONV_WIDTH = 3
EPS = 1e-6

kernel_name = "hybrid_gated_conv_moba_memxattn_block"


def rmsnorm(x, g):
    xf = x.astype(jnp.float32)
    y = xf * lax.rsqrt(jnp.mean(xf * xf, axis=-1, keepdims=True) + EPS)
    return y.astype(x.dtype) * g


def causal_dwconv3(u, w, b):
    s = u.shape[1]
    up = jnp.pad(u, ((0, 0), (2, 0), (0, 0)))
    return up[:, :s] * w[0] + up[:, 1:s + 1] * w[1] + up[:, 2:] * w[2] + b


def moba_attention(q, k, v):
    bsz, s, h, dh = q.shape
    L = MOBA_BLOCK
    nb = -(-s // L)
    sp = nb * L
    pad = ((0, 0), (0, sp - s), (0, 0), (0, 0))
    q, k, v = jnp.pad(q, pad), jnp.pad(k, pad), jnp.pad(v, pad)
    qh = q.transpose(0, 2, 1, 3)
    kb = k.reshape(bsz, nb, L, h, dh).transpose(0, 3, 1, 2, 4)
    vb = v.reshape(bsz, nb, L, h, dh).transpose(0, 3, 1, 2, 4)
    kbar = jnp.mean(kb, axis=3)
    n_sel = min(MOBA_TOPK, nb - 1)
    scale = dh ** -0.5
    gather = jax.vmap(jax.vmap(lambda blocks, idx: blocks[idx]))

    def one_chunk(ci):
        start = ci * MOBA_QCHUNK
        own = start // L
        qc = lax.dynamic_slice_in_dim(qh, start, MOBA_QCHUNK, axis=2)
        qpos = start + jnp.arange(MOBA_QCHUNK)
        kpos = own * L + jnp.arange(L)
        k_own = lax.dynamic_index_in_dim(kb, own, axis=2, keepdims=False)
        v_own = lax.dynamic_index_in_dim(vb, own, axis=2, keepdims=False)
        s_own = jnp.einsum('bhqd,bhkd->bhqk', qc, k_own).astype(jnp.float32) * scale
        s_own = jnp.where(kpos[None, :] <= qpos[:, None], s_own, -jnp.inf)
        if n_sel == 0:
            p = jax.nn.softmax(s_own, axis=-1).astype(v.dtype)
            return jnp.einsum('bhqk,bhkd->bhqd', p, v_own)
        gate = jnp.einsum('bhqd,bhnd->bhqn', qc, kbar)
        gate = jnp.where(jnp.arange(nb) < own, gate, -jnp.inf)
        _, idx = lax.top_k(gate, n_sel)
        valid = idx < own
        k_sel = gather(kb, idx)
        v_sel = gather(vb, idx)
        s_sel = jnp.einsum('bhqd,bhqnkd->bhqnk', qc, k_sel).astype(jnp.float32) * scale
        s_sel = jnp.where(valid[..., None], s_sel, -jnp.inf)
        s_sel = s_sel.reshape(bsz, h, MOBA_QCHUNK, n_sel * L)
        p = jax.nn.softmax(jnp.concatenate([s_sel, s_own], axis=-1), axis=-1).astype(v.dtype)
        p_sel = p[..., :n_sel * L].reshape(bsz, h, MOBA_QCHUNK, n_sel, L)
        p_own = p[..., n_sel * L:]
        return (jnp.einsum('bhqnk,bhqnkd->bhqd', p_sel, v_sel)
                + jnp.einsum('bhqk,bhkd->bhqd', p_own, v_own))

    out = lax.map(one_chunk, jnp.arange(sp // MOBA_QCHUNK))
    out = out.transpose(1, 0, 3, 2, 4).reshape(bsz, sp, h * dh)
    return out[:, :s]


def memory_cross_attention(q_m, mem_n, w_mem_kv, memq_gain, memk_gain):
    bsz, s, _ = q_m.shape
    m = mem_n.shape[1]
    q = rmsnorm(q_m.reshape(bsz, s, MEM_HEADS, MEM_HEAD_DIM), memq_gain)
    k_m, v_m = jnp.split(mem_n @ w_mem_kv, 2, axis=-1)
    k = rmsnorm(k_m.reshape(bsz, m, MEM_HEADS, MEM_HEAD_DIM), memk_gain)
    v = v_m.reshape(bsz, m, MEM_HEADS, MEM_HEAD_DIM)
    sc = jnp.einsum('bshd,bmhd->bhsm', q, k).astype(jnp.float32) * (MEM_HEAD_DIM ** -0.5)
    p = jax.nn.softmax(sc, axis=-1).astype(v.dtype)
    o = jnp.einsum('bhsm,bmhd->bshd', p, v)
    return o.reshape(bsz, s, MEM_WIDTH)


def setup_inputs(seed: int = 0) -> dict:
    key = jax.random.key(seed)
    ks = jax.random.split(key, 24)
    nrm = lambda k, shape, scale: jax.random.normal(k, shape, jnp.float32) * scale
    D = D_MODEL
    return {
        "x": nrm(ks[0], (BATCH, SEQ, D), 1.0),
        "mem": nrm(ks[1], (BATCH, MEM_LEN, D), 1.0),
        "g_mix": 1.0 + nrm(ks[2], (D,), 0.02),
        "w_in": nrm(ks[3], (D, IN_COLS), D ** -0.5),
        "b_gate": nrm(ks[4], (N_BRANCH * D,), 0.02),
        "conv_w": nrm(ks[5], (CONV_WIDTH, CONV_CH), CONV_WIDTH ** -0.5),
        "conv_b": nrm(ks[6], (CONV_CH,), 0.02),
        "moba_q_gain": 1.0 + nrm(ks[7], (MOBA_HEAD_DIM,), 0.02),
        "moba_k_gain": 1.0 + nrm(ks[8], (MOBA_HEAD_DIM,), 0.02),
        "g_mem": 1.0 + nrm(ks[9], (D,), 0.02),
        "w_mem_kv": nrm(ks[10], (D, 2 * MEM_WIDTH), D ** -0.5),
        "memq_gain": 1.0 + nrm(ks[11], (MEM_HEAD_DIM,), 0.02),
        "memk_gain": 1.0 + nrm(ks[12], (MEM_HEAD_DIM,), 0.02),
        "w_br_conv": nrm(ks[13], (CONV_CH, D), CONV_CH ** -0.5),
        "w_br_moba": nrm(ks[14], (MOBA_WIDTH, D), MOBA_WIDTH ** -0.5),
        "w_br_mem": nrm(ks[15], (MEM_WIDTH, D), MEM_WIDTH ** -0.5),
        "w_o": nrm(ks[16], (D, D), D ** -0.5),
        "g_ffn": 1.0 + nrm(ks[17], (D,), 0.02),
        "w_up": nrm(ks[18], (D, 2 * D_FF), D ** -0.5),
        "ffn_conv_w": nrm(ks[19], (FFN_CONV_WIDTH, D_FF), FFN_CONV_WIDTH ** -0.5),
        "ffn_conv_b": nrm(ks[20], (D_FF,), 0.02),
        "w_down": nrm(ks[21], (D_FF, D), D_FF ** -0.5),
    }


def reference(x, mem, g_mix, w_in, b_gate, conv_w, conv_b, moba_q_gain, moba_k_gain,
              g_mem, w_mem_kv, memq_gain, memk_gain, w_br_conv, w_br_moba, w_br_mem,
              w_o, g_ffn, w_up, ffn_conv_w, ffn_conv_b, w_down):
    bsz, s, D = x.shape
    mem_n = rmsnorm(mem, g_mem)
    for _ in range(DEPTH):
        h = rmsnorm(x, g_mix)
        proj = h @ w_in
        cuts = list(np.cumsum(IN_SPLITS)[:-1])
        (c_b, c_c, c_x, q, k, v, q_m, g1, g2, g3) = jnp.split(proj, cuts, axis=-1)
        bg1, bg2, bg3 = jnp.split(b_gate, N_BRANCH)

        y_conv = c_b * causal_dwconv3(c_c * c_x, conv_w, conv_b)

        qh = rmsnorm(q.reshape(bsz, s, MOBA_HEADS, MOBA_HEAD_DIM), moba_q_gain)
        kh = rmsnorm(k.reshape(bsz, s, MOBA_HEADS, MOBA_HEAD_DIM), moba_k_gain)
        vh = v.reshape(bsz, s, MOBA_HEADS, MOBA_HEAD_DIM)
        y_moba = moba_attention(qh, kh, vh)

        y_mem = memory_cross_attention(q_m, mem_n, w_mem_kv, memq_gain, memk_gain)

        merged = (jax.nn.sigmoid(g1 + bg1) * (y_conv @ w_br_conv)
                  + jax.nn.sigmoid(g2 + bg2) * (y_moba @ w_br_moba)
                  + jax.nn.sigmoid(g3 + bg3) * (y_mem @ w_br_mem))
        x = x + merged @ w_o

        h2 = rmsnorm(x, g_ffn)
        a, b = jnp.split(h2 @ w_up, 2, axis=-1)
        a = causal_dwconv3(a, ffn_conv_w, ffn_conv_b)
        x = x + (jax.nn.silu(a) * b) @ w_down
    return x
```

```cpp
#if defined(__HIP_DEVICE_COMPILE__)
#pragma clang attribute push(__attribute__((target("no-packed-fp32-ops"))), apply_to = function)
#endif
#include <hip/hip_runtime.h>
#include <hip/hip_cooperative_groups.h>
#include <cstdio>
#include <cstdint>
namespace cg = cooperative_groups;

#define LAS __attribute__((address_space(3)))
typedef unsigned short bf16_t;
typedef short bf16x8 __attribute__((ext_vector_type(8)));
typedef float f32x4 __attribute__((ext_vector_type(4)));
typedef float f32x16 __attribute__((ext_vector_type(16)));
typedef unsigned u32x4 __attribute__((ext_vector_type(4)));
typedef unsigned u32x2 __attribute__((ext_vector_type(2)));
typedef float f32x2 __attribute__((ext_vector_type(2)));

constexpr int T_TOK = 65536, DM = 1024, SEQ = 4096, NBATCH = 16, NBLK = 16, INC = 6656, DFF = 2816, MEMT = 4096;
constexpr float EPS = 1e-6f;
constexpr float LOG2E = 1.4426950408889634f;
constexpr float C2_MOBA = 0.125f * LOG2E;
constexpr float C2_MEM = 0.08838834764831845f * LOG2E;

__device__ __forceinline__ unsigned cvt_pk_bf16(float lo, float hi) { unsigned r; asm volatile("v_cvt_pk_bf16_f32 %0, %1, %2" : "=v"(r) : "v"(lo), "v"(hi)); return r; }
__device__ __forceinline__ unsigned cvt_pk_bf16_t(float lo, float hi) { unsigned r; asm volatile("s_nop 1\n\tv_cvt_pk_bf16_f32 %0, %1, %2" : "=v"(r) : "v"(lo), "v"(hi)); return r; }
__device__ __forceinline__ float bf_lo(unsigned w) { return __uint_as_float(w << 16); }
__device__ __forceinline__ float bf_hi(unsigned w) { return __uint_as_float(w & 0xffff0000u); }
__device__ __forceinline__ u32x4 pack8(f32x4 a, f32x4 b) { u32x4 w; w.x = cvt_pk_bf16(a[0], a[1]); w.y = cvt_pk_bf16(a[2], a[3]); w.z = cvt_pk_bf16(b[0], b[1]); w.w = cvt_pk_bf16(b[2], b[3]); return w; }
__device__ __forceinline__ u32x4 pack8t(f32x4 a, f32x4 b) { u32x4 w; w.x = cvt_pk_bf16_t(a[0], a[1]); w.y = cvt_pk_bf16_t(a[2], a[3]); w.z = cvt_pk_bf16_t(b[0], b[1]); w.w = cvt_pk_bf16_t(b[2], b[3]); return w; }
__device__ __forceinline__ void unpack8(u32x4 w, f32x4& a, f32x4& b) { a = (f32x4){bf_lo(w.x), bf_hi(w.x), bf_lo(w.y), bf_hi(w.y)}; b = (f32x4){bf_lo(w.z), bf_hi(w.z), bf_lo(w.w), bf_hi(w.w)}; }
__device__ __forceinline__ float fast_sigmoid(float x) { return __builtin_amdgcn_rcpf(1.0f + __builtin_amdgcn_exp2f(x * -LOG2E)); }

struct Params {
    const float* x; const float* mem; const float* g_mix; const float* w_in; const float* b_gate; const float* conv_w; const float* conv_b;
    const float* moba_qg; const float* moba_kg; const float* g_mem; const float* w_mem_kv; const float* memq_g; const float* memk_g;
    const float* w_br_conv; const float* w_br_moba; const float* w_br_mem; const float* w_o; const float* g_ffn; const float* w_up;
    const float* ffn_conv_w; const float* ffn_conv_b; const float* w_down;
    float* out; unsigned char* ws;
    int ph_lo, ph_hi, sub, pad;
};

constexpr size_t MiB = 1u << 20;
constexpr size_t WS_KBAR = 0;
constexpr size_t WS_BAR = 768 * 1024;
constexpr size_t WS_SSQ = 1 * MiB;
constexpr size_t WS_W1T = 5 * MiB;
constexpr size_t WS_WKVT = 18 * MiB;
constexpr size_t WS_WBRT = 20 * MiB;
constexpr size_t WS_WOT = 23 * MiB;
constexpr size_t WS_WUPT = 25 * MiB;
constexpr size_t WS_WDNT = 36 * MiB;
constexpr size_t WS_MEMB = 42 * MiB;
constexpr size_t WS_MEMK = 50 * MiB;
constexpr size_t WS_MEMVT = 54 * MiB;
constexpr size_t WS_VT = 64 * MiB;
constexpr size_t WS_CONV = 128 * MiB;
constexpr size_t WS_QK = 320 * MiB;
constexpr size_t WS_QM = 448 * MiB;
constexpr size_t WS_GATES = 512 * MiB;
constexpr size_t WS_MERGED = 64 * MiB;
constexpr size_t WS_X1B = 192 * MiB;
constexpr size_t WS_AR = 320 * MiB;
constexpr size_t WS_BU = 672 * MiB;
constexpr size_t WS_NEED = 1024 * MiB;

constexpr int LDS_BYTES = 147456;
constexpr int LDS_BARST = LDS_BYTES - 64;

namespace pg8 {
#define PG8_LAS __attribute__((address_space(3)))
constexpr int BM = 256, BK = 64, HALF = 128, HTB = HALF * BK * 2  , STAGE_BYTES = 8 * HTB, NXCD = 8, WGM = 8;

__host__ __device__ __forceinline__ int lds_byte(int r, int c) { const int st = (r >> 4) * 2 + (c >> 5), rr = r & 15, cc = c & 31, ob = rr * 64 + cc * 2; return st * 1024 + (ob ^ (((ob >> 9) & 1) << 5)); }
__host__ __device__ __forceinline__ void stage_rc(int b, int& R, int& C) { const int st = b / 1024, sb = b % 1024, swz = sb ^ (((sb >> 9) & 1) << 5); R = (st >> 1) * 16 + swz / 64; C = (st & 1) * 32 + (swz % 64) / 2; }
__host__ __device__ __forceinline__ int perm32(int rho) { const int n = rho >> 4, i = rho & 15; return 8 * (i >> 2) + 4 * n + (i & 3); }

struct Unit { int pm, pn, seg; };
struct GemmStd { const bf16_t* A; const bf16_t* Bt; int K;
    __device__ __forceinline__ const char* a_ptr(const Unit& u) const { return (const char*)A + (size_t)u.pm * 512 * K; }
    __device__ __forceinline__ const char* b_ptr(const Unit& u) const { return (const char*)Bt + (size_t)u.pn * 512 * K; } };
struct GemmSeg3 { const bf16_t* A0; const bf16_t* A1; const bf16_t* A2; const bf16_t* Bt; int K;
    __device__ __forceinline__ const char* a_ptr(const Unit& u) const { const bf16_t* a = u.seg == 0 ? A0 : (u.seg == 1 ? A1 : A2); return (const char*)a + (size_t)u.pm * 512 * K; }
    __device__ __forceinline__ const char* b_ptr(const Unit& u) const { return (const char*)Bt + (size_t)u.seg * 1024 * K * 2 + (size_t)u.pn * 512 * K; } };

struct StaticOrder {
    int nM, nN, nwg, G, c;
    __host__ __device__ void init(int M, int N, int G_, int c_) { nM = M / BM; nN = N / BM; nwg = nM * nN; G = G_; c = c_; }
    __host__ __device__ bool next(int i, Unit& u) const {
        const long L = (long)i * G + c; if (L >= nwg) return false;
        int wgid = (int)L; { const int q = nwg / NXCD, r = nwg % NXCD, xcd = wgid % NXCD, off = wgid / NXCD; wgid = (xcd < r ? xcd * (q + 1) : r * (q + 1) + (xcd - r) * q) + off; }
        const int nig = WGM * nN, gid = wgid / nig, fm = gid * WGM, gsz = (nM - fm) < WGM ? (nM - fm) : WGM;
        u.pm = fm + ((wgid % nig) % gsz); u.pn = (wgid % nig) / gsz; u.seg = 0; return true;
    }
    __device__ __forceinline__ void a_ready(const Unit&) const {}
    __device__ __forceinline__ void done(const Unit&) const {}
};

template <class Epi, class Sched, class GemmT, bool ALIGN_EPI = false, bool SP2 = false>
__device__ __forceinline__ void gemm_phase(PG8_LAS unsigned char* lds, const GemmT g, const Sched& S, const Epi& E) {
    int tid = threadIdx.x; asm volatile("" : "+v"(tid));
    const int wid = __builtin_amdgcn_readfirstlane(tid >> 6), lane = tid & 63, wr = wid >> 2, wc = wid & 3, fr = lane & 15, fq = lane >> 4;
    const int K = g.K, nt = K / BK;
    unsigned voffA[2], voffB[2];
#pragma unroll
    for (int i = 0; i < 2; ++i) { int R, C; stage_rc(tid * 16 + i * 8192, R, C); const int Rb = Epi::PERM ? ((R & ~31) + perm32(R & 31)) : R;
        voffA[i] = (unsigned)(R * K + C) * 2u; voffB[i] = (unsigned)(Rb * K + C) * 2u; }
    const size_t kstep = (size_t)(BK * 2);
    const size_t hstep = (size_t)HALF * K * 2;

    const unsigned ldsw = (unsigned)wid * 1024u;
    const int aoff = lds_byte(wr * 64 + fr, fq * 8), boff = lds_byte(wc * 32 + fr, fq * 8);
#define PG8_SA(b, h) (((b) * 2 + (h)) * HTB)
#define PG8_SB(b, h) ((4 + (b) * 2 + (h)) * HTB)
#define PG8_STAGE(bufoff, gbase, voff) do { _Pragma("unroll") for (int _i = 0; _i < 2; ++_i) \
        __builtin_amdgcn_global_load_lds((const unsigned*)((const char*)(gbase) + (voff)[_i]), (PG8_LAS unsigned*)(lds + (bufoff) + ldsw + _i * 8192), 16, 0, 0); } while (0)
#define PG8_LDA(dst, b, h) do { _Pragma("unroll") for (int m = 0; m < 4; ++m) _Pragma("unroll") for (int k = 0; k < 2; ++k) dst[m][k] = *(const PG8_LAS bf16x8*)(lds + PG8_SA(b, h) + aoff + m * 2048 + k * 1024); } while (0)
#define PG8_LDB(dst, b, h) do { _Pragma("unroll") for (int n = 0; n < 2; ++n) _Pragma("unroll") for (int k = 0; k < 2; ++k) dst[n][k] = *(const PG8_LAS bf16x8*)(lds + PG8_SB(b, h) + boff + n * 2048 + k * 1024); } while (0)
#define PG8_MMA(ai, bj, At, Bt) do { __builtin_amdgcn_s_setprio(1); _Pragma("unroll") for (int m = 0; m < 4; ++m) _Pragma("unroll") for (int n = 0; n < 2; ++n) _Pragma("unroll") for (int k = 0; k < 2; ++k) \
        acc[ai][bj][m][n] = __builtin_amdgcn_mfma_f32_16x16x32_bf16(Bt[n][k], At[m][k], acc[ai][bj][m][n], 0, 0, 0); __builtin_amdgcn_s_setprio(0); } while (0)
#define PG8_WAIT_V(n) asm volatile("s_waitcnt vmcnt(" #n ")" ::: "memory")
#define PG8_WAIT_L(n) asm volatile("s_waitcnt lgkmcnt(" #n ")" ::: "memory")
#define PG8_BAR __builtin_amdgcn_s_barrier()
#define PG8_SCHED __builtin_amdgcn_sched_barrier(0)
    Unit cur, nxt; int ui = 0;
    if (!S.next(0, cur)) return;
    f32x4 acc[2][2][4][2];
#pragma unroll
    for (int a = 0; a < 2; ++a)
#pragma unroll
        for (int b = 0; b < 2; ++b)
#pragma unroll
            for (int m = 0; m < 4; ++m)
#pragma unroll
                for (int n = 0; n < 2; ++n) acc[a][b][m][n] = (f32x4){0.f, 0.f, 0.f, 0.f};
    bf16x8 At[4][2], B0[2][2], B1[2][2];
    const char* cA = g.a_ptr(cur); const char* cB = g.b_ptr(cur);
    S.a_ready(cur);
    if constexpr (SP2) {
        PG8_STAGE(PG8_SB(0, 0), cB, voffB); PG8_STAGE(PG8_SB(0, 1), cB + hstep, voffB); PG8_STAGE(PG8_SA(0, 0), cA, voffA); PG8_STAGE(PG8_SA(0, 1), cA + hstep, voffA);
        if (wr == 1) PG8_BAR;
        PG8_WAIT_V(2); PG8_BAR;
        PG8_STAGE(PG8_SB(1, 0), cB + kstep, voffB); PG8_STAGE(PG8_SA(1, 0), cA + kstep, voffA); PG8_STAGE(PG8_SB(1, 1), cB + hstep + kstep, voffB);
        PG8_WAIT_V(6); PG8_BAR;
    } else {
        PG8_STAGE(PG8_SB(0, 0), cB, voffB); PG8_STAGE(PG8_SA(0, 0), cA, voffA); PG8_STAGE(PG8_SB(0, 1), cB + hstep, voffB); PG8_STAGE(PG8_SA(0, 1), cA + hstep, voffA);
        if (wr == 1) PG8_BAR;
        PG8_WAIT_V(4); PG8_BAR;
        PG8_STAGE(PG8_SB(1, 0), cB + kstep, voffB); PG8_STAGE(PG8_SA(1, 0), cA + kstep, voffA); PG8_STAGE(PG8_SB(1, 1), cB + hstep + kstep, voffB);
        PG8_WAIT_V(6); PG8_BAR;
    }
    for (;;) {
        const bool has_next = S.next(ui + 1, nxt);
        const char* nA = has_next ? g.a_ptr(nxt) : cA; const char* nB = has_next ? g.b_ptr(nxt) : cB;
        for (int t = 0; t < nt; t += 2) {
            const bool last = (t == nt - 2);
            const char* a1 = cA + (size_t)(t + 1) * kstep;
            const char* a2 = last ? nA : cA + (size_t)(t + 2) * kstep; const char* b2 = last ? nB : cB + (size_t)(t + 2) * kstep;
            const char* a3 = a2 + kstep; const char* b3 = b2 + kstep;
            if (last && has_next) S.a_ready(nxt);
            if constexpr (SP2) {
            PG8_LDB(B0, 0, 0); PG8_LDB(B1, 0, 1); PG8_SCHED; PG8_LDA(At, 0, 0); PG8_STAGE(PG8_SA(1, 1), a1 + hstep, voffA);
            PG8_WAIT_V(8); PG8_WAIT_L(0); PG8_BAR; PG8_MMA(0, 0, At, B0); PG8_MMA(0, 1, At, B1); PG8_BAR; PG8_SCHED;
            PG8_LDA(At, 0, 1); PG8_STAGE(PG8_SB(0, 0), b2, voffB); PG8_STAGE(PG8_SB(0, 1), b2 + hstep, voffB); PG8_STAGE(PG8_SA(0, 0), a2, voffA);
            PG8_WAIT_V(8); PG8_WAIT_L(0); PG8_BAR; PG8_MMA(1, 0, At, B0); PG8_MMA(1, 1, At, B1); PG8_BAR; PG8_SCHED;
            PG8_LDB(B0, 1, 0); PG8_LDB(B1, 1, 1); PG8_SCHED; PG8_LDA(At, 1, 0); PG8_STAGE(PG8_SA(0, 1), a2 + hstep, voffA);
            PG8_WAIT_V(8); PG8_WAIT_L(0); PG8_BAR; PG8_MMA(0, 0, At, B0); PG8_MMA(0, 1, At, B1); PG8_BAR; PG8_SCHED;
            PG8_LDA(At, 1, 1); PG8_STAGE(PG8_SB(1, 0), b3, voffB); PG8_STAGE(PG8_SB(1, 1), b3 + hstep, voffB); PG8_STAGE(PG8_SA(1, 0), a3, voffA);
            PG8_WAIT_V(8); PG8_WAIT_L(0); PG8_BAR; PG8_MMA(1, 0, At, B0); PG8_MMA(1, 1, At, B1); PG8_BAR; PG8_SCHED;
            } else {
            PG8_LDB(B0, 0, 0); PG8_SCHED; PG8_LDA(At, 0, 0); PG8_STAGE(PG8_SA(1, 1), a1 + hstep, voffA);
            PG8_WAIT_L(8); PG8_BAR; PG8_WAIT_L(0); PG8_MMA(0, 0, At, B0); PG8_BAR; PG8_SCHED;
            PG8_LDB(B1, 0, 1); PG8_STAGE(PG8_SB(0, 0), b2, voffB);
            PG8_BAR; PG8_WAIT_L(0); PG8_MMA(0, 1, At, B1); PG8_BAR;
            PG8_LDA(At, 0, 1); PG8_STAGE(PG8_SA(0, 0), a2, voffA);
            PG8_BAR; PG8_WAIT_L(0); PG8_MMA(1, 0, At, B0); PG8_BAR; PG8_SCHED;
            PG8_STAGE(PG8_SB(0, 1), b2 + hstep, voffB);
            PG8_WAIT_V(6); PG8_BAR; PG8_MMA(1, 1, At, B1); PG8_BAR;
            PG8_LDB(B0, 1, 0); PG8_SCHED; PG8_LDA(At, 1, 0); PG8_STAGE(PG8_SA(0, 1), a2 + hstep, voffA);
            PG8_WAIT_L(8); PG8_BAR; PG8_WAIT_L(0); PG8_MMA(0, 0, At, B0); PG8_BAR; PG8_SCHED;
            PG8_LDB(B1, 1, 1); PG8_STAGE(PG8_SB(1, 0), b3, voffB);
            PG8_BAR; PG8_WAIT_L(0); PG8_MMA(0, 1, At, B1); PG8_BAR;
            PG8_LDA(At, 1, 1); PG8_STAGE(PG8_SA(1, 0), a3, voffA);
            PG8_BAR; PG8_WAIT_L(0); PG8_MMA(1, 0, At, B0); PG8_BAR; PG8_SCHED;
            PG8_STAGE(PG8_SB(1, 1), b3 + hstep, voffB);
            PG8_WAIT_V(6); PG8_BAR; PG8_MMA(1, 1, At, B1); PG8_BAR;
            }
        }
        if constexpr (ALIGN_EPI) { if (wr == 0) PG8_BAR; }
        if constexpr (!Epi::AFTER_DRAIN) { E(acc, cur, wr, wc, fr, fq); S.done(cur); }
        if (!has_next) break;
        if (Epi::zero_after(cur))
#pragma unroll
        for (int a = 0; a < 2; ++a)
#pragma unroll
            for (int b = 0; b < 2; ++b)
#pragma unroll
                for (int m = 0; m < 4; ++m)
#pragma unroll
                    for (int n = 0; n < 2; ++n) acc[a][b][m][n] = (f32x4){0.f, 0.f, 0.f, 0.f};
        cur = nxt; cA = nA; cB = nB; ++ui;
        if constexpr (ALIGN_EPI) { if (wr == 1) PG8_BAR; }
    }
    PG8_WAIT_V(0);
    if constexpr (!ALIGN_EPI) { if (wr == 0) PG8_BAR; }
    PG8_BAR;
    if constexpr (Epi::AFTER_DRAIN) { E.fused(acc, cur, wr, wc, fr, fq, lds, wid, lane); S.done(cur); }
#undef PG8_SA
#undef PG8_SB
#undef PG8_STAGE
#undef PG8_LDA
#undef PG8_LDB
#undef PG8_MMA
#undef PG8_WAIT_V
#undef PG8_WAIT_L
#undef PG8_BAR
#undef PG8_SCHED
}
}

using pg8::Unit;
struct SegOrder {
    pg8::StaticOrder base;
    __device__ bool next(int i, Unit& u) const { const int q = i / 3; if (!base.next(q, u)) return false; u.seg = i - 3 * q; return true; }
    __device__ __forceinline__ void a_ready(const Unit&) const {}
    __device__ __forceinline__ void done(const Unit&) const {}
};

struct SubOrder {
    pg8::StaticOrder base; int split, off0, off1;
    __device__ bool next(int i, Unit& u) const { if (!base.next(i, u)) return false; u.pn = u.pn < split ? off0 + u.pn : off1 + (u.pn - split); return true; }
    __device__ __forceinline__ void a_ready(const Unit&) const {}
    __device__ __forceinline__ void done(const Unit&) const {}
};

#define ACC_T f32x4 (&acc)[2][2][4][2]

template <int KIND  > struct EpiIn {
    static constexpr bool PERM = true, AFTER_DRAIN = false;
    static __device__ __forceinline__ bool zero_after(const Unit&) { return true; }
    bf16_t* convb; bf16_t* qk; bf16_t* vT; bf16_t* qm; bf16_t* gates; const float* bgate; const float* qg; const float* kg; float* kbar;
    __device__ __forceinline__ void operator()(ACC_T, const Unit& u, int wr, int wc, int fr, int fq) const {
        const int pn = u.pn;
        const int lc = 64 * wc + 8 * fq;
        const int row0 = u.pm * 256 + wr * 64 + fr;
        if constexpr (KIND == 0) {
            bf16_t* base; int ld, c0;
            asm volatile("" ::: "memory");
            if (pn < 6) { base = convb; ld = 1536; c0 = pn * 256; } else { base = qm; ld = 512; c0 = (pn - 12) * 256; }
#pragma unroll
            for (int ai = 0; ai < 2; ++ai)
#pragma unroll
                for (int m = 0; m < 4; ++m) { const int row = row0 + ai * 128 + m * 16;
#pragma unroll
                    for (int bj = 0; bj < 2; ++bj) *(u32x4*)(base + (size_t)row * ld + c0 + lc + 32 * bj) = pack8(acc[ai][bj][m][0], acc[ai][bj][m][1]); }
        } else if constexpr (KIND == 1) {
            asm volatile("" ::: "memory");
            const bool isk = pn >= 8; const int hl = (pn & 1) * 4 + wc;
            const float* gp = isk ? kg : qg; const float gs = isk ? 1.0f : C2_MOBA;
#pragma unroll
            for (int ai = 0; ai < 2; ++ai)
#pragma unroll
                for (int m = 0; m < 4; ++m) { const int row = row0 + ai * 128 + m * 16;
                    float ss = 0.f;
#pragma unroll
                    for (int bj = 0; bj < 2; ++bj)
#pragma unroll
                        for (int n = 0; n < 2; ++n) { const f32x4 q = acc[ai][bj][m][n] * acc[ai][bj][m][n]; ss += (q[0] + q[1]) + (q[2] + q[3]); }
                    ss += __shfl_xor(ss, 16); ss += __shfl_xor(ss, 32);
                    const float r = rsqrtf(ss * (1.0f / 64.0f) + EPS) * gs;
#pragma unroll
                    for (int bj = 0; bj < 2; ++bj) { asm volatile("" ::: "memory"); const f32x4 g0 = *(const f32x4*)(gp + 32 * bj + 8 * fq), g1 = *(const f32x4*)(gp + 32 * bj + 8 * fq + 4);
                        acc[ai][bj][m][0] = acc[ai][bj][m][0] * r * g0; acc[ai][bj][m][1] = acc[ai][bj][m][1] * r * g1;
                        *(u32x4*)(qk + (size_t)row * 1024 + (isk ? 512 : 0) + hl * 64 + 32 * bj + 8 * fq) = pack8(acc[ai][bj][m][0], acc[ai][bj][m][1]); }
                    __builtin_amdgcn_sched_barrier(0);
                }
            if (isk) {
#pragma unroll
                for (int bj = 0; bj < 2; ++bj)
#pragma unroll
                    for (int n = 0; n < 2; ++n) { f32x4 c4 = acc[0][bj][0][n];
#pragma unroll
                        for (int ai = 0; ai < 2; ++ai)
#pragma unroll
                            for (int m = 0; m < 4; ++m) if (ai + m > 0) c4 = c4 + acc[ai][bj][m][n];
#pragma unroll
                        for (int e = 0; e < 4; ++e) { float sm = c4[e]; sm += __shfl_xor(sm, 1); sm += __shfl_xor(sm, 2); sm += __shfl_xor(sm, 4); sm += __shfl_xor(sm, 8);
                            if (fr == 0) atomicAdd(kbar + ((size_t)((u.pm >> 4) * 8 + hl) * 16 + (u.pm & 15)) * 64 + 32 * bj + 8 * fq + 4 * n + e, sm); } }
            }
        } else if constexpr (KIND == 2) {
            asm volatile("" ::: "memory");
            const int hl = (pn & 1) * 4 + wc; const int b = u.pm >> 4; const int s0 = (u.pm & 15) * 256 + wr * 64 + fr;
            bf16_t* vb = vT + ((size_t)(b * 8 + hl) * 64 + 8 * fq) * 4096 + s0;
#pragma unroll
            for (int ai = 0; ai < 2; ++ai)
#pragma unroll
                for (int m = 0; m < 4; ++m) {
#pragma unroll
                    for (int bj = 0; bj < 2; ++bj)
#pragma unroll
                        for (int n = 0; n < 2; ++n) { const f32x4 v = acc[ai][bj][m][n]; const unsigned w0 = cvt_pk_bf16(v[0], v[1]), w1 = cvt_pk_bf16(v[2], v[3]);
                            bf16_t* p = vb + (size_t)(32 * bj + 4 * n) * 4096 + ai * 128 + m * 16;
                            p[0] = (bf16_t)(w0 & 0xffffu); p[4096] = (bf16_t)(w0 >> 16); p[2 * 4096] = (bf16_t)(w1 & 0xffffu); p[3 * 4096] = (bf16_t)(w1 >> 16); }
                }
        } else {
            asm volatile("" ::: "memory");
            const int gc = (pn - 14) * 256 + lc;
            f32x4 bb[2][2];
#pragma unroll
            for (int bj = 0; bj < 2; ++bj)
#pragma unroll
                for (int n = 0; n < 2; ++n) bb[bj][n] = *(const f32x4*)(bgate + gc + 32 * bj + 4 * n);
#pragma unroll
            for (int ai = 0; ai < 2; ++ai)
#pragma unroll
                for (int m = 0; m < 4; ++m) { const int row = row0 + ai * 128 + m * 16;
#pragma unroll
                    for (int bj = 0; bj < 2; ++bj) { f32x4 v0 = acc[ai][bj][m][0] + bb[bj][0], v1 = acc[ai][bj][m][1] + bb[bj][1];
#pragma unroll
                        for (int e = 0; e < 4; ++e) { v0[e] = fast_sigmoid(v0[e]); v1[e] = fast_sigmoid(v1[e]); }
                        *(u32x4*)(gates + (size_t)row * 3072 + gc + 32 * bj) = pack8t(v0, v1); }
                }
        }
    }
};

struct EpiVT {
    static constexpr bool PERM = true, AFTER_DRAIN = false;
    static __device__ __forceinline__ bool zero_after(const Unit&) { return true; }
    bf16_t* vT;
    __device__ __forceinline__ void operator()(ACC_T, const Unit& u, int wr, int wc, int fr, int fq) const {
        const int tok0 = u.pn * 256 + 32 * wc + 8 * fq;
        const int b = u.pn >> 4, s0 = tok0 & (SEQ - 1);
#pragma unroll
        for (int ai = 0; ai < 2; ++ai)
#pragma unroll
            for (int m = 0; m < 4; ++m) { const int rl = 128 * ai + 64 * wr + 16 * m + fr;
                const int dorig = 64 * ((rl & 127) >> 5) + 32 * (rl >> 7) + (rl & 31);
                const int h = u.pm * 4 + (dorig >> 6), d = dorig & 63;
                bf16_t* p = vT + ((size_t)(b * 8 + h) * 64 + d) * 4096 + s0;
#pragma unroll
                for (int bj = 0; bj < 2; ++bj) *(u32x4*)(p + 128 * bj) = pack8(acc[ai][bj][m][0], acc[ai][bj][m][1]); }
    }
};

struct EpiMemKV {
    static constexpr bool PERM = true, AFTER_DRAIN = false;
    static __device__ __forceinline__ bool zero_after(const Unit&) { return true; }
    bf16_t* memk; bf16_t* memvT;
    __device__ __forceinline__ void operator()(ACC_T, const Unit& u, int wr, int wc, int fr, int fq) const {
        const int row0 = u.pm * 256 + wr * 64 + fr;
#pragma unroll
        for (int ai = 0; ai < 2; ++ai)
#pragma unroll
            for (int m = 0; m < 4; ++m) { const int row = row0 + ai * 128 + m * 16;
#pragma unroll
                for (int bj = 0; bj < 2; ++bj) { const int col = u.pn * 256 + 128 * bj + 32 * wc + 8 * fq;
                    if (u.pn < 2) *(u32x4*)(memk + (size_t)row * 512 + col) = pack8(acc[ai][bj][m][0], acc[ai][bj][m][1]);
                    else { const int c = col - 512, h = c >> 7, d = c & 127; bf16_t* p = memvT + ((size_t)(u.pm * 4 + h) * 128 + d) * 256 + (row & 255);
#pragma unroll
                        for (int n = 0; n < 2; ++n) { const f32x4 v = acc[ai][bj][m][n]; const unsigned w0 = cvt_pk_bf16(v[0], v[1]), w1 = cvt_pk_bf16(v[2], v[3]);
                            bf16_t* q = p + (4 * n) * 256; q[0] = (bf16_t)(w0 & 0xffffu); q[256] = (bf16_t)(w0 >> 16); q[512] = (bf16_t)(w1 & 0xffffu); q[768] = (bf16_t)(w1 >> 16); } }
                } }
    }
};

struct EpiMerge {
    static constexpr bool PERM = true, AFTER_DRAIN = false;
    static __device__ __forceinline__ bool zero_after(const Unit& u) { return u.seg == 2; }
    const bf16_t* gates; bf16_t* merged;
    __device__ __forceinline__ void operator()(ACC_T, const Unit& u, int wr, int wc, int fr, int fq) const {
        const int row0 = u.pm * 256 + wr * 64 + fr; const int seg = u.seg;
#pragma unroll
        for (int ai = 0; ai < 2; ++ai)
#pragma unroll
            for (int m = 0; m < 4; ++m) { const int row = row0 + ai * 128 + m * 16;
#pragma unroll
                for (int bj = 0; bj < 2; ++bj) { const int col = u.pn * 256 + 128 * bj + 32 * wc + 8 * fq;
                    const bf16_t* gp = gates + (size_t)row * 3072 + col;
                    f32x4 a0, a1; unpack8(*(const u32x4*)(gp + (seg == 0 ? 0 : (seg == 1 ? 1024 : 2048))), a0, a1);
                    if (seg < 2) { f32x4 d0, d1; unpack8(*(const u32x4*)(gp + (seg == 0 ? 1024 : 2048)), d0, d1);
#pragma unroll
                        for (int e = 0; e < 4; ++e) { a0[e] = a0[e] * __builtin_amdgcn_rcpf(d0[e]); a1[e] = a1[e] * __builtin_amdgcn_rcpf(d1[e]); } }
                    acc[ai][bj][m][0] = acc[ai][bj][m][0] * a0; acc[ai][bj][m][1] = acc[ai][bj][m][1] * a1;
                    if (seg == 2) *(u32x4*)(merged + (size_t)row * 1024 + col) = pack8(acc[ai][bj][m][0], acc[ai][bj][m][1]);
                } }
    }
};

struct EpiWo {
    static constexpr bool PERM = true, AFTER_DRAIN = false;
    static __device__ __forceinline__ bool zero_after(const Unit&) { return true; }
    const float* x; float* out; bf16_t* x1b; float* ssq;
    __device__ __forceinline__ void operator()(ACC_T, const Unit& u, int wr, int wc, int fr, int fq) const {
        const int row0 = u.pm * 256 + wr * 64 + fr;
#pragma unroll
        for (int ai = 0; ai < 2; ++ai)
#pragma unroll
            for (int m = 0; m < 4; ++m) { const int row = row0 + ai * 128 + m * 16; float ss = 0.f;
#pragma unroll
                for (int bj = 0; bj < 2; ++bj) { const size_t o = (size_t)row * 1024 + u.pn * 256 + 128 * bj + 32 * wc + 8 * fq;
                    const f32x4 v0 = *(const f32x4*)(x + o) + acc[ai][bj][m][0], v1 = *(const f32x4*)(x + o + 4) + acc[ai][bj][m][1];
                    *(f32x4*)(out + o) = v0; *(f32x4*)(out + o + 4) = v1; *(u32x4*)(x1b + o) = pack8(v0, v1);
                    const f32x4 q0 = v0 * v0, q1 = v1 * v1; ss += ((q0[0] + q0[1]) + (q0[2] + q0[3])) + ((q1[0] + q1[1]) + (q1[2] + q1[3])); }
                ss += __shfl_xor(ss, 16); ss += __shfl_xor(ss, 32);
                if (fq == 0) ssq[(size_t)row * 16 + u.pn * 4 + wc] = ss; }
    }
};

template <int CTRL> __device__ __forceinline__ f32x4 dpp4(f32x4 v) { f32x4 r;
#pragma unroll
    for (int e = 0; e < 4; ++e) r[e] = __int_as_float(__builtin_amdgcn_update_dpp(0, __float_as_int(v[e]), CTRL, 0xf, 0xf, true));
    return r; }
struct EpiUp {
    static constexpr bool PERM = true, AFTER_DRAIN = false;
    static __device__ __forceinline__ bool zero_after(const Unit&) { return true; }
    const float* ssq; bf16_t* u; float* halo; const float* cw; const float* cb;
    __device__ __forceinline__ void operator()(ACC_T, const Unit& un, int wr, int wc, int fr, int fq) const {
        const int row0 = un.pm * 256 + wr * 64 + fr; const int col = un.pn * 128 + 32 * wc + 8 * fq;
#pragma unroll
        for (int ai = 0; ai < 2; ++ai)
#pragma unroll
            for (int m = 0; m < 4; ++m) { const int row = row0 + ai * 128 + m * 16;
                const f32x4 s0 = *(const f32x4*)(ssq + (size_t)row * 16 + 4 * fq);
                float tot = (s0[0] + s0[1]) + (s0[2] + s0[3]); tot += __shfl_xor(tot, 16); tot += __shfl_xor(tot, 32);
                const float rs = rsqrtf(tot * (1.0f / 1024.0f) + EPS);
#pragma unroll
                for (int bj = 0; bj < 2; ++bj) { acc[ai][bj][m][0] = acc[ai][bj][m][0] * rs; acc[ai][bj][m][1] = acc[ai][bj][m][1] * rs; } }
        asm volatile("" ::: "memory");
#pragma unroll
        for (int ai = 0; ai < 2; ++ai) {
            const int grp = un.pm * 4 + ai * 2 + wr;
            float* hb = halo + (size_t)grp * 6 * DFF + col;
            if (fr >= 14) { *(f32x4*)(hb + (size_t)(fr - 14) * DFF) = acc[ai][0][3][0]; *(f32x4*)(hb + (size_t)(fr - 14) * DFF + 4) = acc[ai][0][3][1]; }
            if (fr < 2) { *(f32x4*)(hb + (size_t)(2 + fr) * DFF) = acc[ai][0][0][0]; *(f32x4*)(hb + (size_t)(2 + fr) * DFF + 4) = acc[ai][0][0][1];
                          *(f32x4*)(hb + (size_t)(4 + fr) * DFF) = acc[ai][1][0][0]; *(f32x4*)(hb + (size_t)(4 + fr) * DFF + 4) = acc[ai][1][0][1]; }
            __builtin_amdgcn_sched_barrier(0);
#pragma unroll
            for (int n = 0; n < 2; ++n) {
                const f32x4 w0 = *(const f32x4*)(cw + col + 4 * n), w1 = *(const f32x4*)(cw + DFF + col + 4 * n), w2 = *(const f32x4*)(cw + 2 * DFF + col + 4 * n), bi = *(const f32x4*)(cb + col + 4 * n);
#pragma unroll
                for (int m = 0; m < 4; ++m) { const f32x4 a = acc[ai][0][m][n]; const f32x4 ap = m > 0 ? acc[ai][0][m - 1][n] : a;
                    const f32x4 c1 = fr == 15 ? ap : a, c2 = fr >= 14 ? ap : a;
                    const f32x4 p1 = dpp4<0x121>(c1), p2 = dpp4<0x122>(c2);
                    f32x4 z = w0 * p2 + w1 * p1 + w2 * a + bi;
#pragma unroll
                    for (int e = 0; e < 4; ++e) z[e] = z[e] * fast_sigmoid(z[e]);
                    acc[ai][1][m][n] = z * acc[ai][1][m][n];
                    __builtin_amdgcn_sched_barrier(0); }
            }
#pragma unroll
            for (int m = 0; m < 4; ++m) { const int row = row0 + ai * 128 + m * 16;
                *(u32x4*)(u + (size_t)row * DFF + col)     = pack8(acc[ai][1][m][0], acc[ai][1][m][1]); }
        }
    }
};

struct EpiDown {
    static constexpr bool PERM = true, AFTER_DRAIN = false;
    static __device__ __forceinline__ bool zero_after(const Unit&) { return true; }
    float* out;
    __device__ __forceinline__ void operator()(ACC_T, const Unit& u, int wr, int wc, int fr, int fq) const {
        const int row0 = u.pm * 256 + wr * 64 + fr;
#pragma unroll
        for (int ai = 0; ai < 2; ++ai)
#pragma unroll
            for (int m = 0; m < 4; ++m) { const int row = row0 + ai * 128 + m * 16;
#pragma unroll
                for (int bj = 0; bj < 2; ++bj) { const size_t o = (size_t)row * 1024 + u.pn * 256 + 128 * bj + 32 * wc + 8 * fq;
                    *(f32x4*)(out + o) = *(const f32x4*)(out + o) + acc[ai][bj][m][0]; *(f32x4*)(out + o + 4) = *(const f32x4*)(out + o + 4) + acc[ai][bj][m][1]; } }
    }
};

__device__ __forceinline__ float wave_sum(float v) {
#pragma unroll
    for (int o = 1; o < 64; o <<= 1) v += __shfl_xor(v, o);
    return v;
}
__device__ __forceinline__ float wave_max(float v) {
#pragma unroll
    for (int o = 1; o < 64; o <<= 1) v = fmaxf(v, __shfl_xor(v, o));
    return v;
}
__device__ __forceinline__ void transpose_item(const float* __restrict__ W, int N, int K, const float* __restrict__ g, bf16_t* WT, int k0, int scol0, int drow0, LAS float* scr, int lane) {
#pragma unroll 8
    for (int i = 0; i < 32; ++i) { const int kk = 2 * i + (lane >> 5); float v = W[(size_t)(k0 + kk) * N + scol0 + (lane & 31)]; if (g) v *= g[k0 + kk]; scr[kk * 33 + (lane & 31)] = v; }
    asm volatile("s_waitcnt lgkmcnt(0)" ::: "memory");
    const int c = lane & 7;
#pragma unroll
    for (int j = 0; j < 4; ++j) { const int n = (lane >> 3) + 8 * j; const LAS float* s = scr + (8 * c) * 33 + n;
        u32x4 o; o.x = cvt_pk_bf16(s[0 * 33], s[1 * 33]); o.y = cvt_pk_bf16(s[2 * 33], s[3 * 33]); o.z = cvt_pk_bf16(s[4 * 33], s[5 * 33]); o.w = cvt_pk_bf16(s[6 * 33], s[7 * 33]);
        *(u32x4*)(WT + (size_t)(drow0 + n) * K + k0 + 8 * c) = o; }
    asm volatile("s_waitcnt lgkmcnt(0)" ::: "memory");
}
template <int NR> __device__ __forceinline__ void rows_to_bf16(const float* x, bf16_t* o, int m0, int stride, int lane) {
    f32x4 v[NR][4];
#pragma unroll
    for (int r = 0; r < NR; ++r) { const f32x4* xr = (const f32x4*)(x + (size_t)(m0 + r * stride) * 1024) + lane;
#pragma unroll
        for (int j = 0; j < 4; ++j) v[r][j] = xr[64 * j]; }
#pragma unroll
    for (int r = 0; r < NR; ++r) { float s = 0.f;
#pragma unroll
        for (int j = 0; j < 4; ++j) s += (v[r][j].x * v[r][j].x + v[r][j].y * v[r][j].y) + (v[r][j].z * v[r][j].z + v[r][j].w * v[r][j].w);
        s = wave_sum(s);
        const float rs = rsqrtf(s * (1.0f / 1024.0f) + EPS);
        u32x2* o8 = (u32x2*)(o + (size_t)(m0 + r * stride) * 1024) + lane;
#pragma unroll
        for (int j = 0; j < 4; ++j) { const f32x4 t = v[r][j] * rs; o8[64 * j] = (u32x2){cvt_pk_bf16(t.x, t.y), cvt_pk_bf16(t.z, t.w)}; } }
}
__device__ __forceinline__ void phase_prep(const Params& P, LAS unsigned char* lds) {
    const int tid = threadIdx.x, lane = tid & 63, wave = tid >> 6;
    unsigned char* ws = P.ws;
    { float* kb = (float*)(ws + WS_KBAR); for (int i = blockIdx.x * 512 + tid; i < 16 * 8 * 16 * 64; i += gridDim.x * 512) kb[i] = 0.f; }
    LAS float* scr = (LAS float*)(lds + wave * 16384);
    constexpr int I_IN = 16 * (INC / 32), I_KV = 16 * 32, I_BR = 8 * 32, I_O = 16 * 32, I_UP = 16 * (2 * DFF / 32), I_DN = (DFF / 64) * 32;
    constexpr int NIT = I_IN + I_KV + 3 * I_BR + I_O + I_UP + I_DN;
    const int gw2 = blockIdx.x * 4 + (wave & 3), NGW2 = gridDim.x * 4;
    if (wave >= 4) {
    for (int it = gw2; it < NIT; it += NGW2) {
        int r = it;
        if (r < I_IN) { const int nb = r % (INC / 32), kb = r / (INC / 32), d0 = nb * 32, p0 = d0 & 255; const int sc = (d0 & ~255) + 64 * ((p0 & 127) >> 5) + 32 * (p0 >> 7);
            transpose_item(P.w_in, INC, 1024, P.g_mix, (bf16_t*)(ws + WS_W1T), kb * 64, sc, d0, scr, lane); continue; } r -= I_IN;
        if (r < I_KV) { transpose_item(P.w_mem_kv, 1024, 1024, P.g_mem, (bf16_t*)(ws + WS_WKVT), (r / 32) * 64, (r % 32) * 32, (r % 32) * 32, scr, lane); continue; } r -= I_KV;
        if (r < 3 * I_BR) { const int wsel = r / I_BR, q = r % I_BR; const float* W = wsel == 0 ? P.w_br_conv : (wsel == 1 ? P.w_br_moba : P.w_br_mem);
            transpose_item(W, 1024, 512, nullptr, (bf16_t*)(ws + WS_WBRT) + (size_t)wsel * 1024 * 512, (q / 32) * 64, (q % 32) * 32, (q % 32) * 32, scr, lane); continue; } r -= 3 * I_BR;
        if (r < I_O) { transpose_item(P.w_o, 1024, 1024, nullptr, (bf16_t*)(ws + WS_WOT), (r / 32) * 64, (r % 32) * 32, (r % 32) * 32, scr, lane); continue; } r -= I_O;
        if (r < I_UP) { const int nb = r % (2 * DFF / 32), kb = r / (2 * DFF / 32), d0 = nb * 32, p0 = d0 & 255, pn = d0 >> 8; const int sc = p0 < 128 ? pn * 128 + p0 : DFF + pn * 128 + (p0 - 128);
            transpose_item(P.w_up, 2 * DFF, 1024, P.g_ffn, (bf16_t*)(ws + WS_WUPT), kb * 64, sc, d0, scr, lane); continue; } r -= I_UP;
        transpose_item(P.w_down, 1024, DFF, nullptr, (bf16_t*)(ws + WS_WDNT), (r / 32) * 64, (r % 32) * 32, (r % 32) * 32, scr, lane);
    }
    for (int m = gw2; m < MEMT; m += NGW2) rows_to_bf16<1>(P.mem, (bf16_t*)(ws + WS_MEMB), m, NGW2, lane);
    } else {
    bf16_t* xb = (bf16_t*)P.out;
    if ((T_TOK % (4 * NGW2)) == 0) { for (int m = gw2; m < T_TOK; m += 4 * NGW2) rows_to_bf16<4>(P.x, xb, m, NGW2, lane); }
    else { for (int m = gw2; m < T_TOK; m += NGW2) rows_to_bf16<1>(P.x, xb, m, NGW2, lane); }
    }
}

__device__ __forceinline__ int crow(int r, int hi) { return (r & 3) + 8 * (r >> 2) + 4 * hi; }
#define MFMA32(a, b, c) __builtin_amdgcn_mfma_f32_32x32x16_bf16((a), (b), (c), 0, 0, 0)

constexpr int MOBA_KS = 144, MOBA_VS = 520, MOBA_VOFF = 256 * MOBA_KS;
__device__ __forceinline__ unsigned moba_select(const float* kbar, int b, int h, int n, int ql, int hi, const bf16x8 (&qf)[4]) {
    f32x16 g;
#pragma unroll
    for (int i = 0; i < 16; ++i) g[i] = 0.f;
    const float* kb = kbar + ((size_t)(b * 8 + h) * 16 + (ql & 15)) * 64 + 8 * hi;
#pragma unroll
    for (int ks = 0; ks < 4; ++ks) { f32x4 x0 = *(const f32x4*)(kb + 16 * ks), x1 = *(const f32x4*)(kb + 16 * ks + 4);
        if (ql >= 16) { x0 = (f32x4){0.f, 0.f, 0.f, 0.f}; x1 = x0; }
        const u32x4 pk = pack8(x0 * (1.0f / 256.0f), x1 * (1.0f / 256.0f)); g = MFMA32(__builtin_bit_cast(bf16x8, pk), qf[ks], g); }
    float gv[16];
#pragma unroll
    for (int i = 0; i < 8; ++i) { const float own = g[i], oth = __shfl_xor(own, 32); const int bb = (i & 3) + 8 * (i >> 2); gv[bb] = hi ? oth : own; gv[bb + 4] = hi ? own : oth; }
#pragma unroll
    for (int j = 0; j < 16; ++j) if (j >= n) gv[j] = -INFINITY;
    unsigned selmask = 0;
#pragma unroll
    for (int t = 0; t < 3; ++t) { float best = -INFINITY; int bi = -1;
#pragma unroll
        for (int j = 0; j < 16; ++j) if (gv[j] > best) { best = gv[j]; bi = j; }
        if (bi >= 0) selmask |= 1u << bi;
#pragma unroll
        for (int j = 0; j < 16; ++j) if (j == bi) gv[j] = -INFINITY; }
    return selmask;
}
__device__ __forceinline__ void moba_unit(const Params& P, LAS unsigned char* lds, int b, int h, int n, bool first, int nnext, u32x4 (&kr)[4], u32x4 (&vr)[4]) {
    int tid = threadIdx.x; asm volatile("" : "+v"(tid));
    const int lane = tid & 63, w = __builtin_amdgcn_readfirstlane(tid >> 6), ql = lane & 31, hi = lane >> 5, qg = w & 3, kh = w >> 2;
    const bf16_t* qk = (const bf16_t*)(P.ws + WS_QK); const bf16_t* vT = (const bf16_t*)(P.ws + WS_VT); const float* kbar = (const float*)(P.ws + WS_KBAR);
    bf16_t* ymoba = (bf16_t*)P.out + (size_t)T_TOK * 512;
    LAS unsigned char* Ks = lds; LAS unsigned char* Vt = lds + MOBA_VOFF;
    const size_t tq0 = (size_t)b * SEQ + 256 * n + 64 * qg + ql;
    bf16x8 qf[2][4];
#pragma unroll
    for (int c = 0; c < 2; ++c)
#pragma unroll
        for (int ks = 0; ks < 4; ++ks) qf[c][ks] = *(const bf16x8*)(qk + (tq0 + 32 * c) * 1024 + h * 64 + 16 * ks + 8 * hi);
    unsigned selm0 = 0, selm1 = 0;
    if (n > 0) { selm0 = moba_select(kbar, b, h, n, ql, hi, qf[0]); selm1 = moba_select(kbar, b, h, n, ql, hi, qf[1]); }
    f32x16 o[2][2];
#pragma unroll
    for (int c = 0; c < 2; ++c)
#pragma unroll
        for (int d = 0; d < 2; ++d)
#pragma unroll
            for (int i = 0; i < 16; ++i) o[c][d][i] = 0.f;
    float ls[2] = {0.f, 0.f};
    const bf16_t* kbase = qk + ((size_t)b * SEQ) * 1024 + 512 + h * 64; const bf16_t* vbase = vT + ((size_t)(b * 8 + h) * 64) * 4096;
#define MOBA_LOAD(j) do { int t2 = tid; asm volatile("" : "+v"(t2)); _Pragma("unroll") for (int i = 0; i < 4; ++i) { const int p = t2 + 512 * i; \
        kr[i] = *(const u32x4*)(kbase + (size_t)(256 * (j) + (p >> 3)) * 1024 + (p & 7) * 8); \
        vr[i] = *(const u32x4*)(vbase + (size_t)(p >> 5) * 4096 + 256 * (j) + (p & 31) * 8); } } while (0)
    if (first) MOBA_LOAD(n);
    f32x16 zero16;
#pragma unroll
    for (int i = 0; i < 16; ++i) zero16[i] = 0.f;
    for (int it = 0; it <= n; ++it) {
        const int j = (it == 0) ? n : it - 1;
        __syncthreads();
        int t3 = tid; asm volatile("" : "+v"(t3));
#pragma unroll
        for (int i = 0; i < 4; ++i) { const int p = t3 + 512 * i;
            *(LAS u32x4*)(Ks + (p >> 3) * MOBA_KS + (p & 7) * 16) = kr[i];
            LAS unsigned char* vp = Vt + (p >> 5) * MOBA_VS + (p & 31) * 16;
            *(LAS u32x2*)vp = (u32x2){vr[i].x, vr[i].y}; *(LAS u32x2*)(vp + 8) = (u32x2){vr[i].z, vr[i].w}; }
        __syncthreads();
        if (it < n) MOBA_LOAD(it); else if (nnext >= 0) MOBA_LOAD(nnext);
        const bool own = (j == n);
        const bool sel0 = own || ((selm0 >> j) & 1u), sel1 = own || ((selm1 >> j) & 1u);
        if (__ballot(sel0 || sel1) == 0ull) continue;
        const unsigned selw0 = sel0 ? 0xffffffffu : 0u, selw1 = sel1 ? 0xffffffffu : 0u;
        float lb0 = 0.f, lb1 = 0.f;
        const int ntl = own ? (2 * qg + 2 - 4 * kh) : 4;
        for (int t = 0; t < ntl && t < 4; ++t) {
            const int kt = 4 * kh + t;
            const LAS unsigned char* kp = Ks + (32 * kt + ql) * MOBA_KS + 16 * hi;
            bf16x8 kf[4];
#pragma unroll
            for (int ks = 0; ks < 4; ++ks) kf[ks] = *(const LAS bf16x8*)(kp + 32 * ks);
            __builtin_amdgcn_sched_barrier(0);
            f32x16 s0 = MFMA32(kf[0], qf[0][0], zero16);
#pragma unroll
            for (int ks = 1; ks < 4; ++ks) s0 = MFMA32(kf[ks], qf[0][ks], s0);
            f32x16 s1 = MFMA32(kf[0], qf[1][0], zero16);
#pragma unroll
            for (int ks = 1; ks < 4; ++ks) s1 = MFMA32(kf[ks], qf[1][ks], s1);
            __builtin_amdgcn_sched_barrier(0);
            const LAS unsigned char* vp = Vt + ql * MOBA_VS + (32 * kt + 4 * hi) * 2;
            u32x2 vf[2][2][2];
#pragma unroll
            for (int d = 0; d < 2; ++d)
#pragma unroll
                for (int k2 = 0; k2 < 2; ++k2) { vf[d][k2][0] = *(const LAS u32x2*)(vp + 32 * d * MOBA_VS + 32 * k2); vf[d][k2][1] = *(const LAS u32x2*)(vp + 32 * d * MOBA_VS + 32 * k2 + 16); }
            __builtin_amdgcn_sched_barrier(0);
            if (own) {
                if (kt == 2 * qg) {
#pragma unroll
                    for (int i = 0; i < 16; ++i) if (crow(i, hi) > ql) s0[i] = -1e30f;
                }
                if (kt == 2 * qg + 1) {
#pragma unroll
                    for (int i = 0; i < 16; ++i) { s0[i] = -1e30f; if (crow(i, hi) > ql) s1[i] = -1e30f; }
                }
            }
            u32x4 pa[2];
#pragma unroll
            for (int i = 0; i < 8; ++i) { const float e0 = __builtin_amdgcn_exp2f(s0[2 * i]), e1 = __builtin_amdgcn_exp2f(s0[2 * i + 1]); lb0 += e0; lb0 += e1; pa[i >> 2][i & 3] = cvt_pk_bf16_t(e0, e1) & selw0; }
            __builtin_amdgcn_sched_barrier(0);
            bf16x8 av[2][2];
#pragma unroll
            for (int k2 = 0; k2 < 2; ++k2)
#pragma unroll
                for (int d = 0; d < 2; ++d) { const u32x4 a = (u32x4){vf[d][k2][0].x, vf[d][k2][0].y, vf[d][k2][1].x, vf[d][k2][1].y}; av[d][k2] = __builtin_bit_cast(bf16x8, a); }
#pragma unroll
            for (int k2 = 0; k2 < 2; ++k2)
#pragma unroll
                for (int d = 0; d < 2; ++d) o[0][d] = MFMA32(av[d][k2], __builtin_bit_cast(bf16x8, pa[k2]), o[0][d]);
            __builtin_amdgcn_sched_barrier(0);
            u32x4 pb[2];
#pragma unroll
            for (int i = 0; i < 8; ++i) { const float e0 = __builtin_amdgcn_exp2f(s1[2 * i]), e1 = __builtin_amdgcn_exp2f(s1[2 * i + 1]); lb1 += e0; lb1 += e1; pb[i >> 2][i & 3] = cvt_pk_bf16_t(e0, e1) & selw1; }
            __builtin_amdgcn_sched_barrier(0);
#pragma unroll
            for (int k2 = 0; k2 < 2; ++k2)
#pragma unroll
                for (int d = 0; d < 2; ++d) o[1][d] = MFMA32(av[d][k2], __builtin_bit_cast(bf16x8, pb[k2]), o[1][d]);
            __builtin_amdgcn_sched_barrier(0);
        }
        if (sel0) ls[0] += lb0;
        if (sel1) ls[1] += lb1;
    }
#undef MOBA_LOAD
    ls[0] += __shfl_xor(ls[0], 32); ls[1] += __shfl_xor(ls[1], 32);
    __syncthreads();
    LAS float* xo = (LAS float*)lds; LAS float* xl = (LAS float*)(lds + 65536);
    if (kh == 1) {
#pragma unroll
        for (int c = 0; c < 2; ++c) { xl[(qg * 2 + c) * 64 + lane] = ls[c];
#pragma unroll
            for (int d = 0; d < 2; ++d)
#pragma unroll
                for (int i = 0; i < 16; ++i) xo[(((qg * 2 + c) * 2 + d) * 16 + i) * 64 + lane] = o[c][d][i]; }
    }
    __syncthreads();
    if (kh == 0) {
#pragma unroll
        for (int c = 0; c < 2; ++c) { const float inv = 1.0f / (ls[c] + xl[(qg * 2 + c) * 64 + lane]);
            bf16_t* yp = ymoba + (tq0 + 32 * c) * 512 + h * 64 + 4 * hi;
#pragma unroll
            for (int d = 0; d < 2; ++d) {
                float v[16];
#pragma unroll
                for (int i = 0; i < 16; ++i) v[i] = (o[c][d][i] + xo[(((qg * 2 + c) * 2 + d) * 16 + i) * 64 + lane]) * inv;
#pragma unroll
                for (int g4 = 0; g4 < 4; ++g4) *(u32x2*)(yp + 32 * d + 8 * g4) = (u32x2){cvt_pk_bf16(v[4 * g4], v[4 * g4 + 1]), cvt_pk_bf16(v[4 * g4 + 2], v[4 * g4 + 3])}; }
        }
    }
}

constexpr int MEM_KS = 272, MEM_VS = 520, MEM_VOFF = 256 * MEM_KS;
__device__ __forceinline__ void mem_unit(const Params& P, LAS unsigned char* lds, int b, int hm, int qt0) {
    const int tid = threadIdx.x, lane = tid & 63, w = tid >> 6, ql = lane & 31, hi = lane >> 5;
    const bf16_t* qm = (const bf16_t*)(P.ws + WS_QM); const bf16_t* memk = (const bf16_t*)(P.ws + WS_MEMK); const bf16_t* memvT = (const bf16_t*)(P.ws + WS_MEMVT);
    bf16_t* ymem = (bf16_t*)P.out + (size_t)T_TOK * 1024;
    LAS unsigned char* Km = lds; LAS unsigned char* Vm = lds + MEM_VOFF;
    __syncthreads();
#pragma unroll
    for (int i = 0; i < 8; ++i) { const int p = tid + 512 * i, row = p >> 4, c = p & 15;
        f32x4 f0, f1; unpack8(*(const u32x4*)(memk + ((size_t)b * 256 + row) * 512 + hm * 128 + c * 8), f0, f1);
        const f32x4 q0 = f0 * f0, q1 = f1 * f1; float ss = ((q0[0] + q0[1]) + (q0[2] + q0[3])) + ((q1[0] + q1[1]) + (q1[2] + q1[3]));
        ss += __shfl_xor(ss, 1); ss += __shfl_xor(ss, 2); ss += __shfl_xor(ss, 4); ss += __shfl_xor(ss, 8);
        const float rk = rsqrtf(ss * (1.0f / 128.0f) + EPS);
        const f32x4 g0 = *(const f32x4*)(P.memk_g + c * 8), g1 = *(const f32x4*)(P.memk_g + c * 8 + 4);
        *(LAS u32x4*)(Km + row * MEM_KS + c * 16) = pack8(f0 * rk * g0, f1 * rk * g1); }
#pragma unroll
    for (int i = 0; i < 8; ++i) { const int p = tid + 512 * i, d = p >> 5, c = p & 31;
        const u32x4 v = *(const u32x4*)(memvT + ((size_t)(b * 4 + hm) * 128 + d) * 256 + c * 8);
        LAS unsigned char* vp = Vm + d * MEM_VS + c * 16; *(LAS u32x2*)vp = (u32x2){v.x, v.y}; *(LAS u32x2*)(vp + 8) = (u32x2){v.z, v.w}; }
    __syncthreads();
    for (int qt = qt0; qt < qt0 + 4; ++qt) {
        const size_t tq = (size_t)b * SEQ + 256 * qt + 32 * w + ql;
        bf16x8 qf[8];
        { f32x4 f[8][2]; float ss = 0.f;
#pragma unroll
            for (int ks = 0; ks < 8; ++ks) { unpack8(*(const u32x4*)(qm + tq * 512 + hm * 128 + 16 * ks + 8 * hi), f[ks][0], f[ks][1]);
                const f32x4 q0 = f[ks][0] * f[ks][0], q1 = f[ks][1] * f[ks][1]; ss += ((q0[0] + q0[1]) + (q0[2] + q0[3])) + ((q1[0] + q1[1]) + (q1[2] + q1[3])); }
            ss += __shfl_xor(ss, 32);
            const float rq = rsqrtf(ss * (1.0f / 128.0f) + EPS) * C2_MEM;
#pragma unroll
            for (int ks = 0; ks < 8; ++ks) { const f32x4 g0 = *(const f32x4*)(P.memq_g + 16 * ks + 8 * hi), g1 = *(const f32x4*)(P.memq_g + 16 * ks + 8 * hi + 4);
                const u32x4 pk = pack8(f[ks][0] * rq * g0, f[ks][1] * rq * g1); qf[ks] = __builtin_bit_cast(bf16x8, pk); } }
        f32x16 o[4];
#pragma unroll
        for (int d = 0; d < 4; ++d)
#pragma unroll
            for (int i = 0; i < 16; ++i) o[d][i] = 0.f;
        float lsum = 0.f;
        for (int kt = 0; kt < 8; ++kt) {
            f32x16 s;
#pragma unroll
            for (int i = 0; i < 16; ++i) s[i] = 0.f;
            const LAS unsigned char* kp = Km + (32 * kt + ql) * MEM_KS + 16 * hi;
#pragma unroll
            for (int ks = 0; ks < 8; ++ks) s = MFMA32(*(const LAS bf16x8*)(kp + 32 * ks), qf[ks], s);
            float pe[16];
#pragma unroll
            for (int i = 0; i < 16; ++i) { pe[i] = __builtin_amdgcn_exp2f(s[i]); lsum += pe[i]; }
            u32x4 pa0, pa1;
            pa0.x = cvt_pk_bf16_t(pe[0], pe[1]); pa0.y = cvt_pk_bf16_t(pe[2], pe[3]); pa0.z = cvt_pk_bf16_t(pe[4], pe[5]); pa0.w = cvt_pk_bf16_t(pe[6], pe[7]);
            pa1.x = cvt_pk_bf16_t(pe[8], pe[9]); pa1.y = cvt_pk_bf16_t(pe[10], pe[11]); pa1.z = cvt_pk_bf16_t(pe[12], pe[13]); pa1.w = cvt_pk_bf16_t(pe[14], pe[15]);
            const LAS unsigned char* vp = Vm + ql * MEM_VS + (32 * kt + 4 * hi) * 2;
#pragma unroll
            for (int kf = 0; kf < 2; ++kf) { const bf16x8 pb = __builtin_bit_cast(bf16x8, kf ? pa1 : pa0);
#pragma unroll
                for (int d = 0; d < 4; ++d) { const u32x2 lo = *(const LAS u32x2*)(vp + 32 * d * MEM_VS + 32 * kf), h8 = *(const LAS u32x2*)(vp + 32 * d * MEM_VS + 32 * kf + 16);
                    const u32x4 a = (u32x4){lo.x, lo.y, h8.x, h8.y}; o[d] = MFMA32(__builtin_bit_cast(bf16x8, a), pb, o[d]); } }
        }
        lsum += __shfl_xor(lsum, 32);
        const float inv = 1.0f / lsum;
        bf16_t* yp = ymem + tq * 512 + hm * 128 + 4 * hi;
#pragma unroll
        for (int d = 0; d < 4; ++d)
#pragma unroll
            for (int g4 = 0; g4 < 4; ++g4)
                *(u32x2*)(yp + 32 * d + 8 * g4) = (u32x2){cvt_pk_bf16(o[d][4 * g4] * inv, o[d][4 * g4 + 1] * inv), cvt_pk_bf16(o[d][4 * g4 + 2] * inv, o[d][4 * g4 + 3] * inv)};
    }
}

__device__ __forceinline__ void conv_slice(const Params& P, int slice) {
    const bf16_t* cv = (const bf16_t*)(P.ws + WS_CONV); bf16_t* yc = (bf16_t*)P.out;
    const int tid = threadIdx.x;
    for (int i = 0; i < 4; ++i) { const int item = tid + 512 * i, cgp = item & 63, rg = item >> 6; const int t0 = slice * 256 + 8 * rg, c = 8 * cgp;
        f32x4 w0[2], w1[2], w2[2], bi[2];
#pragma unroll
        for (int k = 0; k < 2; ++k) { w0[k] = *(const f32x4*)(P.conv_w + c + 4 * k); w1[k] = *(const f32x4*)(P.conv_w + 512 + c + 4 * k); w2[k] = *(const f32x4*)(P.conv_w + 1024 + c + 4 * k); bi[k] = *(const f32x4*)(P.conv_b + c + 4 * k); }
        const bool first = (t0 & (SEQ - 1)) == 0;
        u32x4 rc[10], rx[10], rb[8];
#pragma unroll
        for (int r = 0; r < 10; ++r) { const size_t t = (size_t)(t0 - 2 + r);
            if (r >= 2 || !first) { rc[r] = *(const u32x4*)(cv + t * 1536 + 512 + c); rx[r] = *(const u32x4*)(cv + t * 1536 + 1024 + c); } else { rc[r] = (u32x4){0u, 0u, 0u, 0u}; rx[r] = rc[r]; }
            if (r >= 2) rb[r - 2] = *(const u32x4*)(cv + t * 1536 + c); }
        f32x4 m2[2], m1[2];
        { f32x4 a0, a1, b0, b1; unpack8(rc[0], a0, a1); unpack8(rx[0], b0, b1); m2[0] = a0 * b0; m2[1] = a1 * b1; unpack8(rc[1], a0, a1); unpack8(rx[1], b0, b1); m1[0] = a0 * b0; m1[1] = a1 * b1; }
#pragma unroll
        for (int r = 0; r < 8; ++r) { const size_t t = (size_t)(t0 + r); f32x4 a0, a1, b0, b1, g0, g1;
            unpack8(rc[r + 2], a0, a1); unpack8(rx[r + 2], b0, b1); unpack8(rb[r], g0, g1);
            const f32x4 m00 = a0 * b0, m01 = a1 * b1;
            const f32x4 y0 = g0 * (w0[0] * m2[0] + w1[0] * m1[0] + w2[0] * m00 + bi[0]), y1 = g1 * (w0[1] * m2[1] + w1[1] * m1[1] + w2[1] * m01 + bi[1]);
            *(u32x4*)(yc + t * 512 + c) = pack8(y0, y1);
            m2[0] = m1[0]; m2[1] = m1[1]; m1[0] = m00; m1[1] = m01; }
    }
}

__device__ __forceinline__ void phase_mixers(const Params& P, LAS unsigned char* lds) {
    if (P.sub & 1) for (int c = blockIdx.x; c < 256; c += gridDim.x) {
        const int bh = c >> 1, odd = c & 1;
        u32x4 kr[4], vr[4];
        for (int i = 0; i < 8; ++i) { const int e = 2 * (i >> 1); const int n = (i & 1) ? (15 - e - odd) : (e + odd);
            const int i2 = i + 1, e2 = 2 * (i2 >> 1); const int nn = i2 < 8 ? ((i2 & 1) ? (15 - e2 - odd) : (e2 + odd)) : -1;
            moba_unit(P, lds, bh >> 3, bh & 7, n, i == 0, nn, kr, vr); }
    }
    if (P.sub & 2) for (int c = blockIdx.x; c < 256; c += gridDim.x) mem_unit(P, lds, c >> 4, (c >> 2) & 3, (c & 3) * 4);
    if (P.sub & 4) for (int c = blockIdx.x; c < 256; c += gridDim.x) conv_slice(P, c);
}

__device__ __forceinline__ void phase_ffn_fix(const Params& P) {
    const float* halo = (const float*)(P.ws + WS_AR); bf16_t* u = (bf16_t*)(P.ws + WS_BU);
    constexpr int CG = DFF / 8;
    const int total = 1024 * 2 * CG;
    for (int idx = blockIdx.x * 512 + threadIdx.x; idx < total; idx += gridDim.x * 512) {
        const int cgp = idx % CG, rr = idx / CG, r = rr & 1, G = rr >> 1, c = cgp * 8;
        const bool seq0 = (G & 63) == 0;
        const float* hg = halo + (size_t)G * 6 * DFF + c; const float* hp = halo + (size_t)(G - 1) * 6 * DFF + c;
        f32x4 z[2];
#pragma unroll
        for (int k = 0; k < 2; ++k) {
            const f32x4 w0 = *(const f32x4*)(P.ffn_conv_w + c + 4 * k), w1 = *(const f32x4*)(P.ffn_conv_w + DFF + c + 4 * k), w2 = *(const f32x4*)(P.ffn_conv_w + 2 * DFF + c + 4 * k), bi = *(const f32x4*)(P.ffn_conv_b + c + 4 * k);
            const f32x4 zero = (f32x4){0.f, 0.f, 0.f, 0.f};
            const f32x4 a = *(const f32x4*)(hg + (size_t)(2 + r) * DFF + 4 * k), b = *(const f32x4*)(hg + (size_t)(4 + r) * DFF + 4 * k);
            f32x4 p1, p2;
            if (r == 0) { p1 = seq0 ? zero : *(const f32x4*)(hp + (size_t)1 * DFF + 4 * k); p2 = seq0 ? zero : *(const f32x4*)(hp + 4 * k); }
            else { p1 = *(const f32x4*)(hg + (size_t)2 * DFF + 4 * k); p2 = seq0 ? zero : *(const f32x4*)(hp + (size_t)1 * DFF + 4 * k); }
            f32x4 t = w0 * p2 + w1 * p1 + w2 * a + bi;
#pragma unroll
            for (int e = 0; e < 4; ++e) t[e] = t[e] * fast_sigmoid(t[e]) * b[e];
            z[k] = t; }
        *(u32x4*)(u + (size_t)(G * 64 + r) * DFF + c) = pack8(z[0], z[1]);
    }
}

#define XB_TMO      128
#define XB_XCNT(j)  (256  + 64 * (j))
#define XB_XSUB(j)  (1280 + 64 * (j))
#define XB_XGEN(j)  (2304 + 64 * (j))
#define XB_TOP      3328
#define XB_TOPGEN   3392
#define XCD_BAR_WORDS 3456
#define XB_SPIN_CAP (1u << 18)

__device__ __forceinline__ unsigned xb_ld(unsigned* p)              { return __hip_atomic_load(p, __ATOMIC_RELAXED, __HIP_MEMORY_SCOPE_AGENT); }
__device__ __forceinline__ unsigned xb_add(unsigned* p, unsigned v) { return __hip_atomic_fetch_add(p, v, __ATOMIC_RELAXED, __HIP_MEMORY_SCOPE_AGENT); }
__device__ __forceinline__ unsigned xb_xcc_id() { return (unsigned)__builtin_amdgcn_s_getreg((3 << 11) | 20) & 0xFu; }
#define XB_SPIN(cond, bar) do { unsigned _sp = 0; while (cond) { __builtin_amdgcn_s_sleep(1); \
    if ((++_sp & 255u) == 0u) { if (xb_ld(&(bar)[XB_TMO])) break; if (_sp > XB_SPIN_CAP) { atomicAdd(&(bar)[XB_TMO], 1u); break; } } } } while (0)

struct XcdBarrier {
    unsigned* bar; unsigned x;
    volatile LAS unsigned* st;
};

__device__ __forceinline__ XcdBarrier xcd_barrier_post(unsigned* bar, volatile LAS unsigned* st) {
    XcdBarrier b; b.bar = bar; b.x = xb_xcc_id(); b.st = st;
    if (threadIdx.x == 0) (void)xb_add(&bar[XB_XCNT(b.x)], 1u);
    return b;
}
__device__ __forceinline__ void xcd_barrier_complete(unsigned* bar, unsigned x, unsigned& nloc, unsigned& nx) {
    const unsigned G = gridDim.x;
    unsigned sum, cnt, mine, sp = 0u;
    for (;;) {
        sum = 0u; cnt = 0u; mine = 0u;
#pragma unroll
        for (unsigned j = 0; j < 16; ++j) { const unsigned c = xb_ld(&bar[XB_XCNT(j)]); sum += c; cnt += (c > 0u) ? 1u : 0u; mine = (j == x) ? c : mine; }
        if (sum == G) break;
        __builtin_amdgcn_s_sleep(1);
        if ((++sp & 255u) == 0u) { if (xb_ld(&bar[XB_TMO])) break; if (sp > XB_SPIN_CAP) { atomicAdd(&bar[XB_TMO], 1u); break; } }
    }
    nloc = mine > 0u ? mine : 1u; nx = cnt > 0u ? cnt : 1u;
}

__device__ __forceinline__ void xcd_barrier(const XcdBarrier& b) {
    asm volatile("s_waitcnt vmcnt(0)" ::: "memory");
    __syncthreads();
    if (threadIdx.x == 0) {
        unsigned* bar = b.bar;
        __builtin_amdgcn_s_waitcnt(0);
        unsigned nloc = b.st[0], nx = b.st[1];
        if (nloc == 0u) { xcd_barrier_complete(bar, b.x, nloc, nx); b.st[0] = nloc; b.st[1] = nx; }
        const unsigned old = xb_add(&bar[XB_XSUB(b.x)], 1u);
        const unsigned gen = old / nloc;
        if (old + 1u == (gen + 1u) * nloc) {
            __builtin_amdgcn_fence(__ATOMIC_RELEASE, "agent");
            asm volatile("s_waitcnt vmcnt(0)" ::: "memory");
            const unsigned og = xb_add(&bar[XB_TOP], 1u);
            const unsigned tg = og / nx;
            if (og + 1u == (tg + 1u) * nx) xb_add(&bar[XB_TOPGEN], 1u);
            else XB_SPIN(xb_ld(&bar[XB_TOPGEN]) == tg, bar);
            __builtin_amdgcn_fence(__ATOMIC_ACQUIRE, "agent");
            xb_add(&bar[XB_XGEN(b.x)], 1u);
            asm volatile("s_waitcnt vmcnt(0)" ::: "memory");
        } else {
            XB_SPIN(xb_ld(&bar[XB_XGEN(b.x)]) == gen, bar);
            __builtin_amdgcn_fence(__ATOMIC_ACQUIRE, "agent");
            asm volatile("s_waitcnt vmcnt(0)" ::: "memory");
        }
    }
    __syncthreads();
}

constexpr int NPHASE = 8;
__global__ void __launch_bounds__(512, 2) mk_fwd(Params P) {
    extern __shared__ __attribute__((aligned(16))) unsigned char lds_raw[];
    LAS unsigned char* lds = (LAS unsigned char*)lds_raw;
    cg::grid_group grid = cg::this_grid();
    unsigned char* ws = P.ws;
    const int G = gridDim.x, bx = blockIdx.x;
    const int lo = P.ph_lo, hi = P.ph_hi;
    volatile LAS unsigned* bst = (volatile LAS unsigned*)(lds + LDS_BARST);
    if (threadIdx.x < 2) bst[threadIdx.x] = 0u;
    __syncthreads();
#ifndef MK_RANGES
    (void)xcd_barrier_post((unsigned*)(ws + WS_BAR), bst);
    if (P.ph_lo < 0) grid.sync();
#endif
#ifndef SUBM
#define SUBM 31
#endif
#ifndef PH_MASK
#define PH_MASK 0xff
#endif
#define IN(k) (((PH_MASK >> (k)) & 1) && lo <= (k) && (k) < hi)
#ifdef MK_RANGES
#define SEAM(k) do { if (IN(k) && IN((k) + 1)) grid.sync(); } while (0)
#else
#define SEAM(k) do { if (IN(k) && IN((k) + 1)) { { XcdBarrier xb_; xb_.bar = (unsigned*)(ws + WS_BAR); xb_.x = xb_xcc_id(); xb_.st = (volatile LAS unsigned*)(lds + LDS_BARST); xcd_barrier(xb_); } } } while (0)
#endif
    if (IN(0)) { phase_prep(P, lds); __syncthreads(); }
    SEAM(0);
#ifdef EXTRA_SYNCS
    for (int i = 0; i < EXTRA_SYNCS; ++i) SEAM(0);
#endif
    if (IN(1)) {
        { pg8::GemmStd g{(const bf16_t*)P.out, (const bf16_t*)(ws + WS_W1T), 1024};
#define EPI_IN_ARGS (bf16_t*)(ws + WS_CONV), (bf16_t*)(ws + WS_QK), (bf16_t*)(ws + WS_VT), (bf16_t*)(ws + WS_QM), (bf16_t*)(ws + WS_GATES), P.b_gate, P.moba_qg, P.moba_kg, (float*)(ws + WS_KBAR)
          if (SUBM & 2) { SubOrder S; S.base.init(T_TOK, 4 * 256, G, bx); S.split = 4; S.off0 = 6; S.off1 = 0; EpiIn<1> E{EPI_IN_ARGS};
            pg8::gemm_phase<EpiIn<1>, SubOrder, pg8::GemmStd, true, true>(lds, g, S, E); }
          if (SUBM & 4) { pg8::GemmStd gv{(const bf16_t*)(ws + WS_W1T) + (size_t)2560 * 1024, (const bf16_t*)P.out, 1024};
            pg8::StaticOrder S; S.init(512, T_TOK, G, bx); EpiVT E{(bf16_t*)(ws + WS_VT)};
            pg8::gemm_phase<EpiVT, pg8::StaticOrder, pg8::GemmStd, true, true>(lds, gv, S, E); }
          if (SUBM & 1) { SubOrder S; S.base.init(T_TOK, 8 * 256, G, bx); S.split = 6; S.off0 = 0; S.off1 = 12; EpiIn<0> E{EPI_IN_ARGS};
            pg8::gemm_phase<EpiIn<0>, SubOrder, pg8::GemmStd, true, true>(lds, g, S, E); }
          if (SUBM & 8) { SubOrder S; S.base.init(T_TOK, 12 * 256, G, bx); S.split = 12; S.off0 = 14; S.off1 = 0; EpiIn<3> E{EPI_IN_ARGS};
            pg8::gemm_phase<EpiIn<3>, SubOrder, pg8::GemmStd, true, true>(lds, g, S, E); }
#undef EPI_IN_ARGS
        }
        if (SUBM & 16) { pg8::GemmStd g{(const bf16_t*)(ws + WS_MEMB), (const bf16_t*)(ws + WS_WKVT), 1024}; pg8::StaticOrder S; S.init(MEMT, 1024, G, bx);
          EpiMemKV E{(bf16_t*)(ws + WS_MEMK), (bf16_t*)(ws + WS_MEMVT)};
          pg8::gemm_phase<EpiMemKV, pg8::StaticOrder, pg8::GemmStd, true, true>(lds, g, S, E); }
    }
    SEAM(1);
    if (IN(2)) { phase_mixers(P, lds); __syncthreads(); }
    SEAM(2);
    if (IN(3)) {
        const bf16_t* y = (const bf16_t*)P.out;
        pg8::GemmSeg3 g{y, y + (size_t)T_TOK * 512, y + (size_t)T_TOK * 1024, (const bf16_t*)(ws + WS_WBRT), 512};
        SegOrder S; S.base.init(T_TOK, 1024, G, bx);
        EpiMerge E{(const bf16_t*)(ws + WS_GATES), (bf16_t*)(ws + WS_MERGED)};
        pg8::gemm_phase<EpiMerge, SegOrder, pg8::GemmSeg3, true, true>(lds, g, S, E);
    }
    SEAM(3);
    if (IN(4)) {
        pg8::GemmStd g{(const bf16_t*)(ws + WS_MERGED), (const bf16_t*)(ws + WS_WOT), 1024}; pg8::StaticOrder S; S.init(T_TOK, 1024, G, bx);
        EpiWo E{P.x, P.out, (bf16_t*)(ws + WS_X1B), (float*)(ws + WS_SSQ)};
        pg8::gemm_phase<EpiWo, pg8::StaticOrder, pg8::GemmStd, true, true>(lds, g, S, E);
    }
    SEAM(4);
    if (IN(5)) {
        pg8::GemmStd g{(const bf16_t*)(ws + WS_X1B), (const bf16_t*)(ws + WS_WUPT), 1024}; pg8::StaticOrder S; S.init(T_TOK, 2 * DFF, G, bx);
        EpiUp E{(const float*)(ws + WS_SSQ), (bf16_t*)(ws + WS_BU), (float*)(ws + WS_AR), P.ffn_conv_w, P.ffn_conv_b};
        pg8::gemm_phase<EpiUp, pg8::StaticOrder, pg8::GemmStd, true, true>(lds, g, S, E);
    }
    SEAM(5);
    if (IN(6)) phase_ffn_fix(P);
    SEAM(6);
    if (IN(7)) {
        pg8::GemmStd g{(const bf16_t*)(ws + WS_BU), (const bf16_t*)(ws + WS_WDNT), DFF}; pg8::StaticOrder S; S.init(T_TOK, 1024, G, bx);
        EpiDown E{P.out};
        pg8::gemm_phase<EpiDown, pg8::StaticOrder, pg8::GemmStd, true, true>(lds, g, S, E);
    }
#undef IN
#undef SEAM
}

#if defined(__HIP_DEVICE_COMPILE__)
#pragma clang attribute pop
#endif
extern "C" void kernel_launch(void* const* d_in, const int* in_sizes, int n_in, void* d_out, int out_size, void* d_ws, size_t ws_size, hipStream_t stream) {
    static int grid = 0;
    if (grid == 0) {
        if (n_in != 22 || in_sizes[0] != T_TOK * DM || out_size != T_TOK * DM || ws_size < WS_NEED) {
            fprintf(stderr, "kernel_launch: unexpected shapes: n_in %d in0 %d out %d ws %zu (need %zu)\n", n_in, n_in > 0 ? in_sizes[0] : -1, out_size, ws_size, (size_t)WS_NEED); grid = -1; return; }
        int dev = 0, cus = 0, per_cu = 0;
        (void)hipGetDevice(&dev); (void)hipDeviceGetAttribute(&cus, hipDeviceAttributeMultiprocessorCount, dev);
        if (hipFuncSetAttribute((const void*)mk_fwd, hipFuncAttributeMaxDynamicSharedMemorySize, LDS_BYTES) != hipSuccess) { fprintf(stderr, "kernel_launch: hipFuncSetAttribute failed\n"); grid = -1; return; }
        if (hipOccupancyMaxActiveBlocksPerMultiprocessor(&per_cu, (const void*)mk_fwd, 512, LDS_BYTES) != hipSuccess || per_cu < 1) { fprintf(stderr, "kernel_launch: occupancy query says %d\n", per_cu); per_cu = 1; }
        (void)hipGetLastError();
        grid = cus * per_cu;
    }
    if (grid < 0) return;
    if (hipMemsetAsync((char*)d_ws + WS_BAR, 0, 16384, stream) != hipSuccess) { fprintf(stderr, "kernel_launch: memset of the barrier words failed\n"); return; }
    Params p{};
    const float** pp = (const float**)&p;
    for (int i = 0; i < 22; ++i) pp[i] = (const float*)d_in[i];
    p.out = (float*)d_out; p.ws = (unsigned char*)d_ws;
#ifdef MK_RANGES
    { const int rg[][3] = MK_RANGES;
      for (unsigned k = 0; k < sizeof(rg) / sizeof(rg[0]); ++k) { p.ph_lo = rg[k][0]; p.ph_hi = rg[k][1]; p.sub = rg[k][2]; void* args[] = {&p};
        hipError_t e = hipLaunchCooperativeKernel((const void*)mk_fwd, dim3(grid), dim3(512), args, LDS_BYTES, stream);
        if (e != hipSuccess) { fprintf(stderr, "launch %u failed: %s\n", k, hipGetErrorString(e)); break; } } }
#else
    p.ph_lo = 0; p.ph_hi = NPHASE; p.sub = 7; void* args[] = {&p};
    hipError_t e = hipLaunchCooperativeKernel((const void*)mk_fwd, dim3(grid), dim3(512), args, LDS_BYTES, stream);
    if (e != hipSuccess) fprintf(stderr, "cooperative launch failed: %s (grid %d)\n", hipGetErrorString(e), grid);
#endif
}
```

```cpp
#if defined(__HIP_DEVICE_COMPILE__)
#pragma clang attribute push(__attribute__((target("no-packed-fp32-ops"))), apply_to = function)
#endif
#include <hip/hip_runtime.h>
#include <hip/hip_cooperative_groups.h>
#include <cstdio>
#include <cstdint>
namespace cg = cooperative_groups;

#define LAS __attribute__((address_space(3)))
typedef unsigned short bf16_t;
typedef short bf16x8 __attribute__((ext_vector_type(8)));
typedef float f32x4 __attribute__((ext_vector_type(4)));
typedef float f32x16 __attribute__((ext_vector_type(16)));
typedef unsigned u32x4 __attribute__((ext_vector_type(4)));
typedef unsigned u32x2 __attribute__((ext_vector_type(2)));
typedef float f32x2 __attribute__((ext_vector_type(2)));

constexpr int T_TOK = 65536, DM = 1024, SEQ = 4096, NBATCH = 16, NBLK = 16, INC = 6656, DFF = 2816, MEMT = 4096;
constexpr float EPS = 1e-6f;
constexpr float LOG2E = 1.4426950408889634f;
constexpr float C2_MOBA = 0.125f * LOG2E;
constexpr float C2_MEM = 0.08838834764831845f * LOG2E;

__device__ __forceinline__ unsigned cvt_pk_bf16(float lo, float hi) { unsigned r; asm volatile("v_cvt_pk_bf16_f32 %0, %1, %2" : "=v"(r) : "v"(lo), "v"(hi)); return r; }
__device__ __forceinline__ unsigned cvt_pk_bf16_t(float lo, float hi) { unsigned r; asm volatile("s_nop 1\n\tv_cvt_pk_bf16_f32 %0, %1, %2" : "=v"(r) : "v"(lo), "v"(hi)); return r; }
__device__ __forceinline__ float bf_lo(unsigned w) { return __uint_as_float(w << 16); }
__device__ __forceinline__ float bf_hi(unsigned w) { return __uint_as_float(w & 0xffff0000u); }
__device__ __forceinline__ u32x4 pack8(f32x4 a, f32x4 b) { u32x4 w; w.x = cvt_pk_bf16(a[0], a[1]); w.y = cvt_pk_bf16(a[2], a[3]); w.z = cvt_pk_bf16(b[0], b[1]); w.w = cvt_pk_bf16(b[2], b[3]); return w; }
__device__ __forceinline__ u32x4 pack8t(f32x4 a, f32x4 b) { u32x4 w; w.x = cvt_pk_bf16_t(a[0], a[1]); w.y = cvt_pk_bf16_t(a[2], a[3]); w.z = cvt_pk_bf16_t(b[0], b[1]); w.w = cvt_pk_bf16_t(b[2], b[3]); return w; }
__device__ __forceinline__ void unpack8(u32x4 w, f32x4& a, f32x4& b) { a = (f32x4){bf_lo(w.x), bf_hi(w.x), bf_lo(w.y), bf_hi(w.y)}; b = (f32x4){bf_lo(w.z), bf_hi(w.z), bf_lo(w.w), bf_hi(w.w)}; }
__device__ __forceinline__ float fast_sigmoid(float x) { return __builtin_amdgcn_rcpf(1.0f + __builtin_amdgcn_exp2f(x * -LOG2E)); }

struct Params {
    const float* x; const float* mem; const float* g_mix; const float* w_in; const float* b_gate; const float* conv_w; const float* conv_b;
    const float* moba_qg; const float* moba_kg; const float* g_mem; const float* w_mem_kv; const float* memq_g; const float* memk_g;
    const float* w_br_conv; const float* w_br_moba; const float* w_br_mem; const float* w_o; const float* g_ffn; const float* w_up;
    const float* ffn_conv_w; const float* ffn_conv_b; const float* w_down;
    float* out; unsigned char* ws;
    int ph_lo, ph_hi, sub, pad;
};

constexpr size_t MiB = 1u << 20;
constexpr size_t WS_KBAR = 0;
constexpr size_t WS_BAR = 768 * 1024;
constexpr size_t WS_SSQ = 1 * MiB;
constexpr size_t WS_W1T = 5 * MiB;
constexpr size_t WS_WKVT = 18 * MiB;
constexpr size_t WS_WBRT = 20 * MiB;
constexpr size_t WS_WOT = 23 * MiB;
constexpr size_t WS_WUPT = 25 * MiB;
constexpr size_t WS_WDNT = 36 * MiB;
constexpr size_t WS_MEMB = 42 * MiB;
constexpr size_t WS_MEMK = 50 * MiB;
constexpr size_t WS_MEMVT = 54 * MiB;
constexpr size_t WS_VT = 64 * MiB;
constexpr size_t WS_CONV = 128 * MiB;
constexpr size_t WS_QK = 320 * MiB;
constexpr size_t WS_QM = 448 * MiB;
constexpr size_t WS_GATES = 512 * MiB;
constexpr size_t WS_MERGED = 64 * MiB;
constexpr size_t WS_X1B = 192 * MiB;
constexpr size_t WS_AR = 320 * MiB;
constexpr size_t WS_BU = 672 * MiB;
constexpr size_t WS_NEED = 1024 * MiB;

constexpr int LDS_BYTES = 147456;
constexpr int LDS_BARST = LDS_BYTES - 64;

namespace pg8 {
#define PG8_LAS __attribute__((address_space(3)))
constexpr int BM = 256, BK = 64, HALF = 128, HTB = HALF * BK * 2  , STAGE_BYTES = 8 * HTB, NXCD = 8, WGM = 8;

__host__ __device__ __forceinline__ int lds_byte(int r, int c) { const int st = (r >> 4) * 2 + (c >> 5), rr = r & 15, cc = c & 31, ob = rr * 64 + cc * 2; return st * 1024 + (ob ^ (((ob >> 9) & 1) << 5)); }
__host__ __device__ __forceinline__ void stage_rc(int b, int& R, int& C) { const int st = b / 1024, sb = b % 1024, swz = sb ^ (((sb >> 9) & 1) << 5); R = (st >> 1) * 16 + swz / 64; C = (st & 1) * 32 + (swz % 64) / 2; }
__host__ __device__ __forceinline__ int perm32(int rho) { const int n = rho >> 4, i = rho & 15; return 8 * (i >> 2) + 4 * n + (i & 3); }

struct Unit { int pm, pn, seg; };
struct GemmStd { const bf16_t* A; const bf16_t* Bt; int K;
    __device__ __forceinline__ const char* a_ptr(const Unit& u) const { return (const char*)A + (size_t)u.pm * 512 * K; }
    __device__ __forceinline__ const char* b_ptr(const Unit& u) const { return (const char*)Bt + (size_t)u.pn * 512 * K; } };
struct GemmSeg3 { const bf16_t* A0; const bf16_t* A1; const bf16_t* A2; const bf16_t* Bt; int K;
    __device__ __forceinline__ const char* a_ptr(const Unit& u) const { const bf16_t* a = u.seg == 0 ? A0 : (u.seg == 1 ? A1 : A2); return (const char*)a + (size_t)u.pm * 512 * K; }
    __device__ __forceinline__ const char* b_ptr(const Unit& u) const { return (const char*)Bt + (size_t)u.seg * 1024 * K * 2 + (size_t)u.pn * 512 * K; } };

struct StaticOrder {
    int nM, nN, nwg, G, c;
    __host__ __device__ void init(int M, int N, int G_, int c_) { nM = M / BM; nN = N / BM; nwg = nM * nN; G = G_; c = c_; }
    __host__ __device__ bool next(int i, Unit& u) const {
        const long L = (long)i * G + c; if (L >= nwg) return false;
        int wgid = (int)L; { const int q = nwg / NXCD, r = nwg % NXCD, xcd = wgid % NXCD, off = wgid / NXCD; wgid = (xcd < r ? xcd * (q + 1) : r * (q + 1) + (xcd - r) * q) + off; }
        const int nig = WGM * nN, gid = wgid / nig, fm = gid * WGM, gsz = (nM - fm) < WGM ? (nM - fm) : WGM;
        u.pm = fm + ((wgid % nig) % gsz); u.pn = (wgid % nig) / gsz; u.seg = 0; return true;
    }
    __device__ __forceinline__ void a_ready(const Unit&) const {}
    __device__ __forceinline__ void done(const Unit&) const {}
};

template <class Epi, class Sched, class GemmT, bool ALIGN_EPI = false, bool SP2 = false>
__device__ __forceinline__ void gemm_phase(PG8_LAS unsigned char* lds, const GemmT g, const Sched& S, const Epi& E) {
    int tid = threadIdx.x; asm volatile("" : "+v"(tid));
    const int wid = __builtin_amdgcn_readfirstlane(tid >> 6), lane = tid & 63, wr = wid >> 2, wc = wid & 3, fr = lane & 15, fq = lane >> 4;
    const int K = g.K, nt = K / BK;
    unsigned voffA[2], voffB[2];
#pragma unroll
    for (int i = 0; i < 2; ++i) { int R, C; stage_rc(tid * 16 + i * 8192, R, C); const int Rb = Epi::PERM ? ((R & ~31) + perm32(R & 31)) : R;
        voffA[i] = (unsigned)(R * K + C) * 2u; voffB[i] = (unsigned)(Rb * K + C) * 2u; }
    const size_t kstep = (size_t)(BK * 2);
    const size_t hstep = (size_t)HALF * K * 2;

    const unsigned ldsw = (unsigned)wid * 1024u;
    const int aoff = lds_byte(wr * 64 + fr, fq * 8), boff = lds_byte(wc * 32 + fr, fq * 8);
#define PG8_SA(b, h) (((b) * 2 + (h)) * HTB)
#define PG8_SB(b, h) ((4 + (b) * 2 + (h)) * HTB)
#define PG8_STAGE(bufoff, gbase, voff) do { _Pragma("unroll") for (int _i = 0; _i < 2; ++_i) \
        __builtin_amdgcn_global_load_lds((const unsigned*)((const char*)(gbase) + (voff)[_i]), (PG8_LAS unsigned*)(lds + (bufoff) + ldsw + _i * 8192), 16, 0, 0); } while (0)
#define PG8_LDA(dst, b, h) do { _Pragma("unroll") for (int m = 0; m < 4; ++m) _Pragma("unroll") for (int k = 0; k < 2; ++k) dst[m][k] = *(const PG8_LAS bf16x8*)(lds + PG8_SA(b, h) + aoff + m * 2048 + k * 1024); } while (0)
#define PG8_LDB(dst, b, h) do { _Pragma("unroll") for (int n = 0; n < 2; ++n) _Pragma("unroll") for (int k = 0; k < 2; ++k) dst[n][k] = *(const PG8_LAS bf16x8*)(lds + PG8_SB(b, h) + boff + n * 2048 + k * 1024); } while (0)
#define PG8_MMA(ai, bj, At, Bt) do { __builtin_amdgcn_s_setprio(1); _Pragma("unroll") for (int m = 0; m < 4; ++m) _Pragma("unroll") for (int n = 0; n < 2; ++n) _Pragma("unroll") for (int k = 0; k < 2; ++k) \
        acc[ai][bj][m][n] = __builtin_amdgcn_mfma_f32_16x16x32_bf16(Bt[n][k], At[m][k], acc[ai][bj][m][n], 0, 0, 0); __builtin_amdgcn_s_setprio(0); } while (0)
#define PG8_WAIT_V(n) asm volatile("s_waitcnt vmcnt(" #n ")" ::: "memory")
#define PG8_WAIT_L(n) asm volatile("s_waitcnt lgkmcnt(" #n ")" ::: "memory")
#define PG8_BAR __builtin_amdgcn_s_barrier()
#define PG8_SCHED __builtin_amdgcn_sched_barrier(0)
    Unit cur, nxt; int ui = 0;
    if (!S.next(0, cur)) return;
    f32x4 acc[2][2][4][2];
#pragma unroll
    for (int a = 0; a < 2; ++a)
#pragma unroll
        for (int b = 0; b < 2; ++b)
#pragma unroll
            for (int m = 0; m < 4; ++m)
#pragma unroll
                for (int n = 0; n < 2; ++n) acc[a][b][m][n] = (f32x4){0.f, 0.f, 0.f, 0.f};
    bf16x8 At[4][2], B0[2][2], B1[2][2];
    const char* cA = g.a_ptr(cur); const char* cB = g.b_ptr(cur);
    S.a_ready(cur);
    if constexpr (SP2) {
        PG8_STAGE(PG8_SB(0, 0), cB, voffB); PG8_STAGE(PG8_SB(0, 1), cB + hstep, voffB); PG8_STAGE(PG8_SA(0, 0), cA, voffA); PG8_STAGE(PG8_SA(0, 1), cA + hstep, voffA);
        if (wr == 1) PG8_BAR;
        PG8_WAIT_V(2); PG8_BAR;
        PG8_STAGE(PG8_SB(1, 0), cB + kstep, voffB); PG8_STAGE(PG8_SA(1, 0), cA + kstep, voffA); PG8_STAGE(PG8_SB(1, 1), cB + hstep + kstep, voffB);
        PG8_WAIT_V(6); PG8_BAR;
    } else {
        PG8_STAGE(PG8_SB(0, 0), cB, voffB); PG8_STAGE(PG8_SA(0, 0), cA, voffA); PG8_STAGE(PG8_SB(0, 1), cB + hstep, voffB); PG8_STAGE(PG8_SA(0, 1), cA + hstep, voffA);
        if (wr == 1) PG8_BAR;
        PG8_WAIT_V(4); PG8_BAR;
        PG8_STAGE(PG8_SB(1, 0), cB + kstep, voffB); PG8_STAGE(PG8_SA(1, 0), cA + kstep, voffA); PG8_STAGE(PG8_SB(1, 1), cB + hstep + kstep, voffB);
        PG8_WAIT_V(6); PG8_BAR;
    }
    for (;;) {
        const bool has_next = S.next(ui + 1, nxt);
        const char* nA = has_next ? g.a_ptr(nxt) : cA; const char* nB = has_next ? g.b_ptr(nxt) : cB;
        for (int t = 0; t < nt; t += 2) {
            const bool last = (t == nt - 2);
            const char* a1 = cA + (size_t)(t + 1) * kstep;
            const char* a2 = last ? nA : cA + (size_t)(t + 2) * kstep; const char* b2 = last ? nB : cB + (size_t)(t + 2) * kstep;
            const char* a3 = a2 + kstep; const char* b3 = b2 + kstep;
            if (last && has_next) S.a_ready(nxt);
            if constexpr (SP2) {
            PG8_LDB(B0, 0, 0); PG8_LDB(B1, 0, 1); PG8_SCHED; PG8_LDA(At, 0, 0); PG8_STAGE(PG8_SA(1, 1), a1 + hstep, voffA);
            PG8_WAIT_V(8); PG8_WAIT_L(0); PG8_BAR; PG8_MMA(0, 0, At, B0); PG8_MMA(0, 1, At, B1); PG8_BAR; PG8_SCHED;
            PG8_LDA(At, 0, 1); PG8_STAGE(PG8_SB(0, 0), b2, voffB); PG8_STAGE(PG8_SB(0, 1), b2 + hstep, voffB); PG8_STAGE(PG8_SA(0, 0), a2, voffA);
            PG8_WAIT_V(8); PG8_WAIT_L(0); PG8_BAR; PG8_MMA(1, 0, At, B0); PG8_MMA(1, 1, At, B1); PG8_BAR; PG8_SCHED;
            PG8_LDB(B0, 1, 0); PG8_LDB(B1, 1, 1); PG8_SCHED; PG8_LDA(At, 1, 0); PG8_STAGE(PG8_SA(0, 1), a2 + hstep, voffA);
            PG8_WAIT_V(8); PG8_WAIT_L(0); PG8_BAR; PG8_MMA(0, 0, At, B0); PG8_MMA(0, 1, At, B1); PG8_BAR; PG8_SCHED;
            PG8_LDA(At, 1, 1); PG8_STAGE(PG8_SB(1, 0), b3, voffB); PG8_STAGE(PG8_SB(1, 1), b3 + hstep, voffB); PG8_STAGE(PG8_SA(1, 0), a3, voffA);
            PG8_WAIT_V(8); PG8_WAIT_L(0); PG8_BAR; PG8_MMA(1, 0, At, B0); PG8_MMA(1, 1, At, B1); PG8_BAR; PG8_SCHED;
            } else {
            PG8_LDB(B0, 0, 0); PG8_SCHED; PG8_LDA(At, 0, 0); PG8_STAGE(PG8_SA(1, 1), a1 + hstep, voffA);
            PG8_WAIT_L(8); PG8_BAR; PG8_WAIT_L(0); PG8_MMA(0, 0, At, B0); PG8_BAR; PG8_SCHED;
            PG8_LDB(B1, 0, 1); PG8_STAGE(PG8_SB(0, 0), b2, voffB);
            PG8_BAR; PG8_WAIT_L(0); PG8_MMA(0, 1, At, B1); PG8_BAR;
            PG8_LDA(At, 0, 1); PG8_STAGE(PG8_SA(0, 0), a2, voffA);
            PG8_BAR; PG8_WAIT_L(0); PG8_MMA(1, 0, At, B0); PG8_BAR; PG8_SCHED;
            PG8_STAGE(PG8_SB(0, 1), b2 + hstep, voffB);
            PG8_WAIT_V(6); PG8_BAR; PG8_MMA(1, 1, At, B1); PG8_BAR;
            PG8_LDB(B0, 1, 0); PG8_SCHED; PG8_LDA(At, 1, 0); PG8_STAGE(PG8_SA(0, 1), a2 + hstep, voffA);
            PG8_WAIT_L(8); PG8_BAR; PG8_WAIT_L(0); PG8_MMA(0, 0, At, B0); PG8_BAR; PG8_SCHED;
            PG8_LDB(B1, 1, 1); PG8_STAGE(PG8_SB(1, 0), b3, voffB);
            PG8_BAR; PG8_WAIT_L(0); PG8_MMA(0, 1, At, B1); PG8_BAR;
            PG8_LDA(At, 1, 1); PG8_STAGE(PG8_SA(1, 0), a3, voffA);
            PG8_BAR; PG8_WAIT_L(0); PG8_MMA(1, 0, At, B0); PG8_BAR; PG8_SCHED;
            PG8_STAGE(PG8_SB(1, 1), b3 + hstep, voffB);
            PG8_WAIT_V(6); PG8_BAR; PG8_MMA(1, 1, At, B1); PG8_BAR;
            }
        }
        if constexpr (ALIGN_EPI) { if (wr == 0) PG8_BAR; }
        if constexpr (!Epi::AFTER_DRAIN) { E(acc, cur, wr, wc, fr, fq); S.done(cur); }
        if (!has_next) break;
        if (Epi::zero_after(cur))
#pragma unroll
        for (int a = 0; a < 2; ++a)
#pragma unroll
            for (int b = 0; b < 2; ++b)
#pragma unroll
                for (int m = 0; m < 4; ++m)
#pragma unroll
                    for (int n = 0; n < 2; ++n) acc[a][b][m][n] = (f32x4){0.f, 0.f, 0.f, 0.f};
        cur = nxt; cA = nA; cB = nB; ++ui;
        if constexpr (ALIGN_EPI) { if (wr == 1) PG8_BAR; }
    }
    PG8_WAIT_V(0);
    if constexpr (!ALIGN_EPI) { if (wr == 0) PG8_BAR; }
    PG8_BAR;
    if constexpr (Epi::AFTER_DRAIN) { E.fused(acc, cur, wr, wc, fr, fq, lds, wid, lane); S.done(cur); }
#undef PG8_SA
#undef PG8_SB
#undef PG8_STAGE
#undef PG8_LDA
#undef PG8_LDB
#undef PG8_MMA
#undef PG8_WAIT_V
#undef PG8_WAIT_L
#undef PG8_BAR
#undef PG8_SCHED
}
}

using pg8::Unit;
struct SegOrder {
    pg8::StaticOrder base;
    __device__ bool next(int i, Unit& u) const { const int q = i / 3; if (!base.next(q, u)) return false; u.seg = i - 3 * q; return true; }
    __device__ __forceinline__ void a_ready(const Unit&) const {}
    __device__ __forceinline__ void done(const Unit&) const {}
};

struct SubOrder {
    pg8::StaticOrder base; int split, off0, off1;
    __device__ bool next(int i, Unit& u) const { if (!base.next(i, u)) return false; u.pn = u.pn < split ? off0 + u.pn : off1 + (u.pn - split); return true; }
    __device__ __forceinline__ void a_ready(const Unit&) const {}
    __device__ __forceinline__ void done(const Unit&) const {}
};

#define ACC_T f32x4 (&acc)[2][2][4][2]

template <int KIND  > struct EpiIn {
    static constexpr bool PERM = true, AFTER_DRAIN = false;
    static __device__ __forceinline__ bool zero_after(const Unit&) { return true; }
    bf16_t* convb; bf16_t* qk; bf16_t* vT; bf16_t* qm; bf16_t* gates; const float* bgate; const float* qg; const float* kg; float* kbar;
    __device__ __forceinline__ void operator()(ACC_T, const Unit& u, int wr, int wc, int fr, int fq) const {
        const int pn = u.pn;
        const int lc = 64 * wc + 8 * fq;
        const int row0 = u.pm * 256 + wr * 64 + fr;
        if constexpr (KIND == 0) {
            bf16_t* base; int ld, c0;
            asm volatile("" ::: "memory");
            if (pn < 6) { base = convb; ld = 1536; c0 = pn * 256; } else { base = qm; ld = 512; c0 = (pn - 12) * 256; }
#pragma unroll
            for (int ai = 0; ai < 2; ++ai)
#pragma unroll
                for (int m = 0; m < 4; ++m) { const int row = row0 + ai * 128 + m * 16;
#pragma unroll
                    for (int bj = 0; bj < 2; ++bj) *(u32x4*)(base + (size_t)row * ld + c0 + lc + 32 * bj) = pack8(acc[ai][bj][m][0], acc[ai][bj][m][1]); }
        } else if constexpr (KIND == 1) {
            asm volatile("" ::: "memory");
            const bool isk = pn >= 8; const int hl = (pn & 1) * 4 + wc;
            const float* gp = isk ? kg : qg; const float gs = isk ? 1.0f : C2_MOBA;
#pragma unroll
            for (int ai = 0; ai < 2; ++ai)
#pragma unroll
                for (int m = 0; m < 4; ++m) { const int row = row0 + ai * 128 + m * 16;
                    float ss = 0.f;
#pragma unroll
                    for (int bj = 0; bj < 2; ++bj)
#pragma unroll
                        for (int n = 0; n < 2; ++n) { const f32x4 q = acc[ai][bj][m][n] * acc[ai][bj][m][n]; ss += (q[0] + q[1]) + (q[2] + q[3]); }
                    ss += __shfl_xor(ss, 16); ss += __shfl_xor(ss, 32);
                    const float r = rsqrtf(ss * (1.0f / 64.0f) + EPS) * gs;
#pragma unroll
                    for (int bj = 0; bj < 2; ++bj) { asm volatile("" ::: "memory"); const f32x4 g0 = *(const f32x4*)(gp + 32 * bj + 8 * fq), g1 = *(const f32x4*)(gp + 32 * bj + 8 * fq + 4);
                        acc[ai][bj][m][0] = acc[ai][bj][m][0] * r * g0; acc[ai][bj][m][1] = acc[ai][bj][m][1] * r * g1;
                        *(u32x4*)(qk + (size_t)row * 1024 + (isk ? 512 : 0) + hl * 64 + 32 * bj + 8 * fq) = pack8(acc[ai][bj][m][0], acc[ai][bj][m][1]); }
                    __builtin_amdgcn_sched_barrier(0);
                }
            if (isk) {
#pragma unroll
                for (int bj = 0; bj < 2; ++bj)
#pragma unroll
                    for (int n = 0; n < 2; ++n) { f32x4 c4 = acc[0][bj][0][n];
#pragma unroll
                        for (int ai = 0; ai < 2; ++ai)
#pragma unroll
                            for (int m = 0; m < 4; ++m) if (ai + m > 0) c4 = c4 + acc[ai][bj][m][n];
#pragma unroll
                        for (int e = 0; e < 4; ++e) { float sm = c4[e]; sm += __shfl_xor(sm, 1); sm += __shfl_xor(sm, 2); sm += __shfl_xor(sm, 4); sm += __shfl_xor(sm, 8);
                            if (fr == 0) atomicAdd(kbar + ((size_t)((u.pm >> 4) * 8 + hl) * 16 + (u.pm & 15)) * 64 + 32 * bj + 8 * fq + 4 * n + e, sm); } }
            }
        } else if constexpr (KIND == 2) {
            asm volatile("" ::: "memory");
            const int hl = (pn & 1) * 4 + wc; const int b = u.pm >> 4; const int s0 = (u.pm & 15) * 256 + wr * 64 + fr;
            bf16_t* vb = vT + ((size_t)(b * 8 + hl) * 64 + 8 * fq) * 4096 + s0;
#pragma unroll
            for (int ai = 0; ai < 2; ++ai)
#pragma unroll
                for (int m = 0; m < 4; ++m) {
#pragma unroll
                    for (int bj = 0; bj < 2; ++bj)
#pragma unroll
                        for (int n = 0; n < 2; ++n) { const f32x4 v = acc[ai][bj][m][n]; const unsigned w0 = cvt_pk_bf16(v[0], v[1]), w1 = cvt_pk_bf16(v[2], v[3]);
                            bf16_t* p = vb + (size_t)(32 * bj + 4 * n) * 4096 + ai * 128 + m * 16;
                            p[0] = (bf16_t)(w0 & 0xffffu); p[4096] = (bf16_t)(w0 >> 16); p[2 * 4096] = (bf16_t)(w1 & 0xffffu); p[3 * 4096] = (bf16_t)(w1 >> 16); }
                }
        } else {
            asm volatile("" ::: "memory");
            const int gc = (pn - 14) * 256 + lc;
            f32x4 bb[2][2];
#pragma unroll
            for (int bj = 0; bj < 2; ++bj)
#pragma unroll
                for (int n = 0; n < 2; ++n) bb[bj][n] = *(const f32x4*)(bgate + gc + 32 * bj + 4 * n);
#pragma unroll
            for (int ai = 0; ai < 2; ++ai)
#pragma unroll
                for (int m = 0; m < 4; ++m) { const int row = row0 + ai * 128 + m * 16;
#pragma unroll
                    for (int bj = 0; bj < 2; ++bj) { f32x4 v0 = acc[ai][bj][m][0] + bb[bj][0], v1 = acc[ai][bj][m][1] + bb[bj][1];
#pragma unroll
                        for (int e = 0; e < 4; ++e) { v0[e] = fast_sigmoid(v0[e]); v1[e] = fast_sigmoid(v1[e]); }
                        *(u32x4*)(gates + (size_t)row * 3072 + gc + 32 * bj) = pack8t(v0, v1); }
                }
        }
    }
};

struct EpiVT {
    static constexpr bool PERM = true, AFTER_DRAIN = false;
    static __device__ __forceinline__ bool zero_after(const Unit&) { return true; }
    bf16_t* vT;
    __device__ __forceinline__ void operator()(ACC_T, const Unit& u, int wr, int wc, int fr, int fq) const {
        const int tok0 = u.pn * 256 + 32 * wc + 8 * fq;
        const int b = u.pn >> 4, s0 = tok0 & (SEQ - 1);
#pragma unroll
        for (int ai = 0; ai < 2; ++ai)
#pragma unroll
            for (int m = 0; m < 4; ++m) { const int rl = 128 * ai + 64 * wr + 16 * m + fr;
                const int dorig = 64 * ((rl & 127) >> 5) + 32 * (rl >> 7) + (rl & 31);
                const int h = u.pm * 4 + (dorig >> 6), d = dorig & 63;
                bf16_t* p = vT + ((size_t)(b * 8 + h) * 64 + d) * 4096 + s0;
#pragma unroll
                for (int bj = 0; bj < 2; ++bj) *(u32x4*)(p + 128 * bj) = pack8(acc[ai][bj][m][0], acc[ai][bj][m][1]); }
    }
};

struct EpiMemKV {
    static constexpr bool PERM = true, AFTER_DRAIN = false;
    static __device__ __forceinline__ bool zero_after(const Unit&) { return true; }
    bf16_t* memk; bf16_t* memvT;
    __device__ __forceinline__ void operator()(ACC_T, const Unit& u, int wr, int wc, int fr, int fq) const {
        const int row0 = u.pm * 256 + wr * 64 + fr;
#pragma unroll
        for (int ai = 0; ai < 2; ++ai)
#pragma unroll
            for (int m = 0; m < 4; ++m) { const int row = row0 + ai * 128 + m * 16;
#pragma unroll
                for (int bj = 0; bj < 2; ++bj) { const int col = u.pn * 256 + 128 * bj + 32 * wc + 8 * fq;
                    if (u.pn < 2) *(u32x4*)(memk + (size_t)row * 512 + col) = pack8(acc[ai][bj][m][0], acc[ai][bj][m][1]);
                    else { const int c = col - 512, h = c >> 7, d = c & 127; bf16_t* p = memvT + ((size_t)(u.pm * 4 + h) * 128 + d) * 256 + (row & 255);
#pragma unroll
                        for (int n = 0; n < 2; ++n) { const f32x4 v = acc[ai][bj][m][n]; const unsigned w0 = cvt_pk_bf16(v[0], v[1]), w1 = cvt_pk_bf16(v[2], v[3]);
                            bf16_t* q = p + (4 * n) * 256; q[0] = (bf16_t)(w0 & 0xffffu); q[256] = (bf16_t)(w0 >> 16); q[512] = (bf16_t)(w1 & 0xffffu); q[768] = (bf16_t)(w1 >> 16); } }
                } }
    }
};

struct EpiMerge {
    static constexpr bool PERM = true, AFTER_DRAIN = false;
    static __device__ __forceinline__ bool zero_after(const Unit& u) { return u.seg == 2; }
    const bf16_t* gates; bf16_t* merged;
    __device__ __forceinline__ void operator()(ACC_T, const Unit& u, int wr, int wc, int fr, int fq) const {
        const int row0 = u.pm * 256 + wr * 64 + fr; const int seg = u.seg;
#pragma unroll
        for (int ai = 0; ai < 2; ++ai)
#pragma unroll
            for (int m = 0; m < 4; ++m) { const int row = row0 + ai * 128 + m * 16;
#pragma unroll
                for (int bj = 0; bj < 2; ++bj) { const int col = u.pn * 256 + 128 * bj + 32 * wc + 8 * fq;
                    const bf16_t* gp = gates + (size_t)row * 3072 + col;
                    f32x4 a0, a1; unpack8(*(const u32x4*)(gp + (seg == 0 ? 0 : (seg == 1 ? 1024 : 2048))), a0, a1);
                    if (seg < 2) { f32x4 d0, d1; unpack8(*(const u32x4*)(gp + (seg == 0 ? 1024 : 2048)), d0, d1);
#pragma unroll
                        for (int e = 0; e < 4; ++e) { a0[e] = a0[e] * __builtin_amdgcn_rcpf(d0[e]); a1[e] = a1[e] * __builtin_amdgcn_rcpf(d1[e]); } }
                    acc[ai][bj][m][0] = acc[ai][bj][m][0] * a0; acc[ai][bj][m][1] = acc[ai][bj][m][1] * a1;
                    if (seg == 2) *(u32x4*)(merged + (size_t)row * 1024 + col) = pack8(acc[ai][bj][m][0], acc[ai][bj][m][1]);
                } }
    }
};

struct EpiWo {
    static constexpr bool PERM = true, AFTER_DRAIN = false;
    static __device__ __forceinline__ bool zero_after(const Unit&) { return true; }
    const float* x; float* out; bf16_t* x1b; float* ssq;
    __device__ __forceinline__ void operator()(ACC_T, const Unit& u, int wr, int wc, int fr, int fq) const {
        const int row0 = u.pm * 256 + wr * 64 + fr;
#pragma unroll
        for (int ai = 0; ai < 2; ++ai)
#pragma unroll
            for (int m = 0; m < 4; ++m) { const int row = row0 + ai * 128 + m * 16; float ss = 0.f;
#pragma unroll
                for (int bj = 0; bj < 2; ++bj) { const size_t o = (size_t)row * 1024 + u.pn * 256 + 128 * bj + 32 * wc + 8 * fq;
                    const f32x4 v0 = *(const f32x4*)(x + o) + acc[ai][bj][m][0], v1 = *(const f32x4*)(x + o + 4) + acc[ai][bj][m][1];
                    *(f32x4*)(out + o) = v0; *(f32x4*)(out + o + 4) = v1; *(u32x4*)(x1b + o) = pack8(v0, v1);
                    const f32x4 q0 = v0 * v0, q1 = v1 * v1; ss += ((q0[0] + q0[1]) + (q0[2] + q0[3])) + ((q1[0] + q1[1]) + (q1[2] + q1[3])); }
                ss += __shfl_xor(ss, 16); ss += __shfl_xor(ss, 32);
                if (fq == 0) ssq[(size_t)row * 16 + u.pn * 4 + wc] = ss; }
    }
};

template <int CTRL> __device__ __forceinline__ f32x4 dpp4(f32x4 v) { f32x4 r;
#pragma unroll
    for (int e = 0; e < 4; ++e) r[e] = __int_as_float(__builtin_amdgcn_update_dpp(0, __float_as_int(v[e]), CTRL, 0xf, 0xf, true));
    return r; }
struct EpiUp {
    static constexpr bool PERM = true, AFTER_DRAIN = false;
    static __device__ __forceinline__ bool zero_after(const Unit&) { return true; }
    const float* ssq; bf16_t* u; float* halo; const float* cw; const float* cb;
    __device__ __forceinline__ void operator()(ACC_T, const Unit& un, int wr, int wc, int fr, int fq) const {
        const int row0 = un.pm * 256 + wr * 64 + fr; const int col = un.pn * 128 + 32 * wc + 8 * fq;
#pragma unroll
        for (int ai = 0; ai < 2; ++ai)
#pragma unroll
            for (int m = 0; m < 4; ++m) { const int row = row0 + ai * 128 + m * 16;
                const f32x4 s0 = *(const f32x4*)(ssq + (size_t)row * 16 + 4 * fq);
                float tot = (s0[0] + s0[1]) + (s0[2] + s0[3]); tot += __shfl_xor(tot, 16); tot += __shfl_xor(tot, 32);
                const float rs = rsqrtf(tot * (1.0f / 1024.0f) + EPS);
#pragma unroll
                for (int bj = 0; bj < 2; ++bj) { acc[ai][bj][m][0] = acc[ai][bj][m][0] * rs; acc[ai][bj][m][1] = acc[ai][bj][m][1] * rs; } }
        asm volatile("" ::: "memory");
#pragma unroll
        for (int ai = 0; ai < 2; ++ai) {
            const int grp = un.pm * 4 + ai * 2 + wr;
            float* hb = halo + (size_t)grp * 6 * DFF + col;
            if (fr >= 14) { *(f32x4*)(hb + (size_t)(fr - 14) * DFF) = acc[ai][0][3][0]; *(f32x4*)(hb + (size_t)(fr - 14) * DFF + 4) = acc[ai][0][3][1]; }
            if (fr < 2) { *(f32x4*)(hb + (size_t)(2 + fr) * DFF) = acc[ai][0][0][0]; *(f32x4*)(hb + (size_t)(2 + fr) * DFF + 4) = acc[ai][0][0][1];
                          *(f32x4*)(hb + (size_t)(4 + fr) * DFF) = acc[ai][1][0][0]; *(f32x4*)(hb + (size_t)(4 + fr) * DFF + 4) = acc[ai][1][0][1]; }
            __builtin_amdgcn_sched_barrier(0);
#pragma unroll
            for (int n = 0; n < 2; ++n) {
                const f32x4 w0 = *(const f32x4*)(cw + col + 4 * n), w1 = *(const f32x4*)(cw + DFF + col + 4 * n), w2 = *(const f32x4*)(cw + 2 * DFF + col + 4 * n), bi = *(const f32x4*)(cb + col + 4 * n);
#pragma unroll
                for (int m = 0; m < 4; ++m) { const f32x4 a = acc[ai][0][m][n]; const f32x4 ap = m > 0 ? acc[ai][0][m - 1][n] : a;
                    const f32x4 c1 = fr == 15 ? ap : a, c2 = fr >= 14 ? ap : a;
                    const f32x4 p1 = dpp4<0x121>(c1), p2 = dpp4<0x122>(c2);
                    f32x4 z = w0 * p2 + w1 * p1 + w2 * a + bi;
#pragma unroll
                    for (int e = 0; e < 4; ++e) z[e] = z[e] * fast_sigmoid(z[e]);
                    acc[ai][1][m][n] = z * acc[ai][1][m][n];
                    }
            }
#pragma unroll
            for (int m = 0; m < 4; ++m) { const int row = row0 + ai * 128 + m * 16;
                *(u32x4*)(u + (size_t)row * DFF + col)     = pack8(acc[ai][1][m][0], acc[ai][1][m][1]); }
        }
    }
};

struct EpiDown {
    static constexpr bool PERM = true, AFTER_DRAIN = false;
    static __device__ __forceinline__ bool zero_after(const Unit&) { return true; }
    float* out;
    __device__ __forceinline__ void operator()(ACC_T, const Unit& u, int wr, int wc, int fr, int fq) const {
        const int row0 = u.pm * 256 + wr * 64 + fr;
#pragma unroll
        for (int ai = 0; ai < 2; ++ai)
#pragma unroll
            for (int m = 0; m < 4; ++m) { const int row = row0 + ai * 128 + m * 16;
#pragma unroll
                for (int bj = 0; bj < 2; ++bj) { const size_t o = (size_t)row * 1024 + u.pn * 256 + 128 * bj + 32 * wc + 8 * fq;
                    *(f32x4*)(out + o) = *(const f32x4*)(out + o) + acc[ai][bj][m][0]; *(f32x4*)(out + o + 4) = *(const f32x4*)(out + o + 4) + acc[ai][bj][m][1]; } }
    }
};

__device__ __forceinline__ float wave_sum(float v) {
#pragma unroll
    for (int o = 1; o < 64; o <<= 1) v += __shfl_xor(v, o);
    return v;
}
__device__ __forceinline__ float wave_max(float v) {
#pragma unroll
    for (int o = 1; o < 64; o <<= 1) v = fmaxf(v, __shfl_xor(v, o));
    return v;
}
__device__ __forceinline__ void transpose_item(const float* __restrict__ W, int N, int K, const float* __restrict__ g, bf16_t* WT, int k0, int scol0, int drow0, LAS float* scr, int lane) {
#pragma unroll 8
    for (int i = 0; i < 32; ++i) { const int kk = 2 * i + (lane >> 5); float v = W[(size_t)(k0 + kk) * N + scol0 + (lane & 31)]; if (g) v *= g[k0 + kk]; scr[kk * 33 + (lane & 31)] = v; }
    asm volatile("s_waitcnt lgkmcnt(0)" ::: "memory");
    const int c = lane & 7;
#pragma unroll
    for (int j = 0; j < 4; ++j) { const int n = (lane >> 3) + 8 * j; const LAS float* s = scr + (8 * c) * 33 + n;
        u32x4 o; o.x = cvt_pk_bf16(s[0 * 33], s[1 * 33]); o.y = cvt_pk_bf16(s[2 * 33], s[3 * 33]); o.z = cvt_pk_bf16(s[4 * 33], s[5 * 33]); o.w = cvt_pk_bf16(s[6 * 33], s[7 * 33]);
        *(u32x4*)(WT + (size_t)(drow0 + n) * K + k0 + 8 * c) = o; }
    asm volatile("s_waitcnt lgkmcnt(0)" ::: "memory");
}
template <int NR> __device__ __forceinline__ void rows_to_bf16(const float* x, bf16_t* o, int m0, int stride, int lane) {
    f32x4 v[NR][4];
#pragma unroll
    for (int r = 0; r < NR; ++r) { const f32x4* xr = (const f32x4*)(x + (size_t)(m0 + r * stride) * 1024) + lane;
#pragma unroll
        for (int j = 0; j < 4; ++j) v[r][j] = xr[64 * j]; }
#pragma unroll
    for (int r = 0; r < NR; ++r) { float s = 0.f;
#pragma unroll
        for (int j = 0; j < 4; ++j) s += (v[r][j].x * v[r][j].x + v[r][j].y * v[r][j].y) + (v[r][j].z * v[r][j].z + v[r][j].w * v[r][j].w);
        s = wave_sum(s);
        const float rs = rsqrtf(s * (1.0f / 1024.0f) + EPS);
        u32x2* o8 = (u32x2*)(o + (size_t)(m0 + r * stride) * 1024) + lane;
#pragma unroll
        for (int j = 0; j < 4; ++j) { const f32x4 t = v[r][j] * rs; o8[64 * j] = (u32x2){cvt_pk_bf16(t.x, t.y), cvt_pk_bf16(t.z, t.w)}; } }
}
__device__ __forceinline__ void phase_prep(const Params& P, LAS unsigned char* lds) {
    const int tid = threadIdx.x, lane = tid & 63, wave = tid >> 6;
    const int gw = blockIdx.x * 8 + wave, NGW = gridDim.x * 8;
    unsigned char* ws = P.ws;
    { float* kb = (float*)(ws + WS_KBAR); for (int i = blockIdx.x * 512 + tid; i < 16 * 8 * 16 * 64; i += gridDim.x * 512) kb[i] = 0.f; }
    LAS float* scr = (LAS float*)(lds + wave * 16384);
    constexpr int I_IN = 16 * (INC / 32), I_KV = 16 * 32, I_BR = 8 * 32, I_O = 16 * 32, I_UP = 16 * (2 * DFF / 32), I_DN = (DFF / 64) * 32;
    constexpr int NIT = I_IN + I_KV + 3 * I_BR + I_O + I_UP + I_DN;
    for (int it = gw; it < NIT; it += NGW) {
        int r = it;
        if (r < I_IN) { const int nb = r % (INC / 32), kb = r / (INC / 32), d0 = nb * 32, p0 = d0 & 255; const int sc = (d0 & ~255) + 64 * ((p0 & 127) >> 5) + 32 * (p0 >> 7);
            transpose_item(P.w_in, INC, 1024, P.g_mix, (bf16_t*)(ws + WS_W1T), kb * 64, sc, d0, scr, lane); continue; } r -= I_IN;
        if (r < I_KV) { transpose_item(P.w_mem_kv, 1024, 1024, P.g_mem, (bf16_t*)(ws + WS_WKVT), (r / 32) * 64, (r % 32) * 32, (r % 32) * 32, scr, lane); continue; } r -= I_KV;
        if (r < 3 * I_BR) { const int wsel = r / I_BR, q = r % I_BR; const float* W = wsel == 0 ? P.w_br_conv : (wsel == 1 ? P.w_br_moba : P.w_br_mem);
            transpose_item(W, 1024, 512, nullptr, (bf16_t*)(ws + WS_WBRT) + (size_t)wsel * 1024 * 512, (q / 32) * 64, (q % 32) * 32, (q % 32) * 32, scr, lane); continue; } r -= 3 * I_BR;
        if (r < I_O) { transpose_item(P.w_o, 1024, 1024, nullptr, (bf16_t*)(ws + WS_WOT), (r / 32) * 64, (r % 32) * 32, (r % 32) * 32, scr, lane); continue; } r -= I_O;
        if (r < I_UP) { const int nb = r % (2 * DFF / 32), kb = r / (2 * DFF / 32), d0 = nb * 32, p0 = d0 & 255, pn = d0 >> 8; const int sc = p0 < 128 ? pn * 128 + p0 : DFF + pn * 128 + (p0 - 128);
            transpose_item(P.w_up, 2 * DFF, 1024, P.g_ffn, (bf16_t*)(ws + WS_WUPT), kb * 64, sc, d0, scr, lane); continue; } r -= I_UP;
        transpose_item(P.w_down, 1024, DFF, nullptr, (bf16_t*)(ws + WS_WDNT), (r / 32) * 64, (r % 32) * 32, (r % 32) * 32, scr, lane);
    }
    bf16_t* xb = (bf16_t*)P.out;
    if ((T_TOK % (4 * NGW)) == 0) { for (int m = gw; m < T_TOK; m += 4 * NGW) rows_to_bf16<4>(P.x, xb, m, NGW, lane); }
    else { for (int m = gw; m < T_TOK; m += NGW) rows_to_bf16<1>(P.x, xb, m, NGW, lane); }
    for (int m = gw; m < MEMT; m += NGW) rows_to_bf16<1>(P.mem, (bf16_t*)(ws + WS_MEMB), m, NGW, lane);
}

__device__ __forceinline__ int crow(int r, int hi) { return (r & 3) + 8 * (r >> 2) + 4 * hi; }
#define MFMA32(a, b, c) __builtin_amdgcn_mfma_f32_32x32x16_bf16((a), (b), (c), 0, 0, 0)

constexpr int MOBA_KS = 144, MOBA_VS = 520, MOBA_VOFF = 256 * MOBA_KS;
__device__ __forceinline__ unsigned moba_select(const float* kbar, int b, int h, int n, int ql, int hi, const bf16x8 (&qf)[4]) {
    f32x16 g;
#pragma unroll
    for (int i = 0; i < 16; ++i) g[i] = 0.f;
    const float* kb = kbar + ((size_t)(b * 8 + h) * 16 + (ql & 15)) * 64 + 8 * hi;
#pragma unroll
    for (int ks = 0; ks < 4; ++ks) { f32x4 x0 = *(const f32x4*)(kb + 16 * ks), x1 = *(const f32x4*)(kb + 16 * ks + 4);
        if (ql >= 16) { x0 = (f32x4){0.f, 0.f, 0.f, 0.f}; x1 = x0; }
        const u32x4 pk = pack8(x0 * (1.0f / 256.0f), x1 * (1.0f / 256.0f)); g = MFMA32(__builtin_bit_cast(bf16x8, pk), qf[ks], g); }
    float gv[16];
#pragma unroll
    for (int i = 0; i < 8; ++i) { const float own = g[i], oth = __shfl_xor(own, 32); const int bb = (i & 3) + 8 * (i >> 2); gv[bb] = hi ? oth : own; gv[bb + 4] = hi ? own : oth; }
#pragma unroll
    for (int j = 0; j < 16; ++j) if (j >= n) gv[j] = -INFINITY;
    unsigned selmask = 0;
#pragma unroll
    for (int t = 0; t < 3; ++t) { float best = -INFINITY; int bi = -1;
#pragma unroll
        for (int j = 0; j < 16; ++j) if (gv[j] > best) { best = gv[j]; bi = j; }
        if (bi >= 0) selmask |= 1u << bi;
#pragma unroll
        for (int j = 0; j < 16; ++j) if (j == bi) gv[j] = -INFINITY; }
    return selmask;
}
__device__ __forceinline__ void moba_unit(const Params& P, LAS unsigned char* lds, int b, int h, int n, bool first, int nnext, u32x4 (&kr)[4], u32x4 (&vr)[4]) {
    int tid = threadIdx.x; asm volatile("" : "+v"(tid));
    const int lane = tid & 63, w = __builtin_amdgcn_readfirstlane(tid >> 6), ql = lane & 31, hi = lane >> 5, qg = w & 3, kh = w >> 2;
    const bf16_t* qk = (const bf16_t*)(P.ws + WS_QK); const bf16_t* vT = (const bf16_t*)(P.ws + WS_VT); const float* kbar = (const float*)(P.ws + WS_KBAR);
    bf16_t* ymoba = (bf16_t*)P.out + (size_t)T_TOK * 512;
    LAS unsigned char* Ks = lds; LAS unsigned char* Vt = lds + MOBA_VOFF;
    const size_t tq0 = (size_t)b * SEQ + 256 * n + 64 * qg + ql;
    bf16x8 qf[2][4];
#pragma unroll
    for (int c = 0; c < 2; ++c)
#pragma unroll
        for (int ks = 0; ks < 4; ++ks) qf[c][ks] = *(const bf16x8*)(qk + (tq0 + 32 * c) * 1024 + h * 64 + 16 * ks + 8 * hi);
    unsigned selm0 = 0, selm1 = 0;
    if (n > 0) { selm0 = moba_select(kbar, b, h, n, ql, hi, qf[0]); selm1 = moba_select(kbar, b, h, n, ql, hi, qf[1]); }
    f32x16 o[2][2];
#pragma unroll
    for (int c = 0; c < 2; ++c)
#pragma unroll
        for (int d = 0; d < 2; ++d)
#pragma unroll
            for (int i = 0; i < 16; ++i) o[c][d][i] = 0.f;
    float ls[2] = {0.f, 0.f};
    const bf16_t* kbase = qk + ((size_t)b * SEQ) * 1024 + 512 + h * 64; const bf16_t* vbase = vT + ((size_t)(b * 8 + h) * 64) * 4096;
#define MOBA_LOAD(j) do { int t2 = tid; asm volatile("" : "+v"(t2)); _Pragma("unroll") for (int i = 0; i < 4; ++i) { const int p = t2 + 512 * i; \
        kr[i] = *(const u32x4*)(kbase + (size_t)(256 * (j) + (p >> 3)) * 1024 + (p & 7) * 8); \
        vr[i] = *(const u32x4*)(vbase + (size_t)(p >> 5) * 4096 + 256 * (j) + (p & 31) * 8); } } while (0)
    if (first) MOBA_LOAD(n);
    f32x16 zero16;
#pragma unroll
    for (int i = 0; i < 16; ++i) zero16[i] = 0.f;
    for (int it = 0; it <= n; ++it) {
        const int j = (it == 0) ? n : it - 1;
        __syncthreads();
        int t3 = tid; asm volatile("" : "+v"(t3));
#pragma unroll
        for (int i = 0; i < 4; ++i) { const int p = t3 + 512 * i;
            *(LAS u32x4*)(Ks + (p >> 3) * MOBA_KS + (p & 7) * 16) = kr[i];
            LAS unsigned char* vp = Vt + (p >> 5) * MOBA_VS + (p & 31) * 16;
            *(LAS u32x2*)vp = (u32x2){vr[i].x, vr[i].y}; *(LAS u32x2*)(vp + 8) = (u32x2){vr[i].z, vr[i].w}; }
        __syncthreads();
        if (it < n) MOBA_LOAD(it); else if (nnext >= 0) MOBA_LOAD(nnext);
        const bool own = (j == n);
        const bool sel0 = own || ((selm0 >> j) & 1u), sel1 = own || ((selm1 >> j) & 1u);
        if (__ballot(sel0 || sel1) == 0ull) continue;
        const unsigned selw0 = sel0 ? 0xffffffffu : 0u, selw1 = sel1 ? 0xffffffffu : 0u;
        float lb0 = 0.f, lb1 = 0.f;
        const int ntl = own ? (2 * qg + 2 - 4 * kh) : 4;
        for (int t = 0; t < ntl && t < 4; ++t) {
            const int kt = 4 * kh + t;
            const LAS unsigned char* kp = Ks + (32 * kt + ql) * MOBA_KS + 16 * hi;
            bf16x8 kf[4];
#pragma unroll
            for (int ks = 0; ks < 4; ++ks) kf[ks] = *(const LAS bf16x8*)(kp + 32 * ks);
            __builtin_amdgcn_sched_barrier(0);
            f32x16 s0 = MFMA32(kf[0], qf[0][0], zero16);
#pragma unroll
            for (int ks = 1; ks < 4; ++ks) s0 = MFMA32(kf[ks], qf[0][ks], s0);
            f32x16 s1 = MFMA32(kf[0], qf[1][0], zero16);
#pragma unroll
            for (int ks = 1; ks < 4; ++ks) s1 = MFMA32(kf[ks], qf[1][ks], s1);
            __builtin_amdgcn_sched_barrier(0);
            const LAS unsigned char* vp = Vt + ql * MOBA_VS + (32 * kt + 4 * hi) * 2;
            u32x2 vf[2][2][2];
#pragma unroll
            for (int d = 0; d < 2; ++d)
#pragma unroll
                for (int k2 = 0; k2 < 2; ++k2) { vf[d][k2][0] = *(const LAS u32x2*)(vp + 32 * d * MOBA_VS + 32 * k2); vf[d][k2][1] = *(const LAS u32x2*)(vp + 32 * d * MOBA_VS + 32 * k2 + 16); }
            __builtin_amdgcn_sched_barrier(0);
            if (own) {
                if (kt == 2 * qg) {
#pragma unroll
                    for (int i = 0; i < 16; ++i) if (crow(i, hi) > ql) s0[i] = -1e30f;
                }
                if (kt == 2 * qg + 1) {
#pragma unroll
                    for (int i = 0; i < 16; ++i) { s0[i] = -1e30f; if (crow(i, hi) > ql) s1[i] = -1e30f; }
                }
            }
            u32x4 pa[2];
#pragma unroll
            for (int i = 0; i < 8; ++i) { const float e0 = __builtin_amdgcn_exp2f(s0[2 * i]), e1 = __builtin_amdgcn_exp2f(s0[2 * i + 1]); lb0 += e0; lb0 += e1; pa[i >> 2][i & 3] = cvt_pk_bf16_t(e0, e1) & selw0; }
            __builtin_amdgcn_sched_barrier(0);
            bf16x8 av[2][2];
#pragma unroll
            for (int k2 = 0; k2 < 2; ++k2)
#pragma unroll
                for (int d = 0; d < 2; ++d) { const u32x4 a = (u32x4){vf[d][k2][0].x, vf[d][k2][0].y, vf[d][k2][1].x, vf[d][k2][1].y}; av[d][k2] = __builtin_bit_cast(bf16x8, a); }
#pragma unroll
            for (int k2 = 0; k2 < 2; ++k2)
#pragma unroll
                for (int d = 0; d < 2; ++d) o[0][d] = MFMA32(av[d][k2], __builtin_bit_cast(bf16x8, pa[k2]), o[0][d]);
            __builtin_amdgcn_sched_barrier(0);
            u32x4 pb[2];
#pragma unroll
            for (int i = 0; i < 8; ++i) { const float e0 = __builtin_amdgcn_exp2f(s1[2 * i]), e1 = __builtin_amdgcn_exp2f(s1[2 * i + 1]); lb1 += e0; lb1 += e1; pb[i >> 2][i & 3] = cvt_pk_bf16_t(e0, e1) & selw1; }
            __builtin_amdgcn_sched_barrier(0);
#pragma unroll
            for (int k2 = 0; k2 < 2; ++k2)
#pragma unroll
                for (int d = 0; d < 2; ++d) o[1][d] = MFMA32(av[d][k2], __builtin_bit_cast(bf16x8, pb[k2]), o[1][d]);
            __builtin_amdgcn_sched_barrier(0);
        }
        if (sel0) ls[0] += lb0;
        if (sel1) ls[1] += lb1;
    }
#undef MOBA_LOAD
    ls[0] += __shfl_xor(ls[0], 32); ls[1] += __shfl_xor(ls[1], 32);
    __syncthreads();
    LAS float* xo = (LAS float*)lds; LAS float* xl = (LAS float*)(lds + 65536);
    if (kh == 1) {
#pragma unroll
        for (int c = 0; c < 2; ++c) { xl[(qg * 2 + c) * 64 + lane] = ls[c];
#pragma unroll
            for (int d = 0; d < 2; ++d)
#pragma unroll
                for (int i = 0; i < 16; ++i) xo[(((qg * 2 + c) * 2 + d) * 16 + i) * 64 + lane] = o[c][d][i]; }
    }
    __syncthreads();
    if (kh == 0) {
#pragma unroll
        for (int c = 0; c < 2; ++c) { const float inv = 1.0f / (ls[c] + xl[(qg * 2 + c) * 64 + lane]);
            bf16_t* yp = ymoba + (tq0 + 32 * c) * 512 + h * 64 + 4 * hi;
#pragma unroll
            for (int d = 0; d < 2; ++d) {
                float v[16];
#pragma unroll
                for (int i = 0; i < 16; ++i) v[i] = (o[c][d][i] + xo[(((qg * 2 + c) * 2 + d) * 16 + i) * 64 + lane]) * inv;
#pragma unroll
                for (int g4 = 0; g4 < 4; ++g4) *(u32x2*)(yp + 32 * d + 8 * g4) = (u32x2){cvt_pk_bf16(v[4 * g4], v[4 * g4 + 1]), cvt_pk_bf16(v[4 * g4 + 2], v[4 * g4 + 3])}; }
        }
    }
}

constexpr int MEM_KS = 272, MEM_VS = 520, MEM_VOFF = 256 * MEM_KS;
__device__ __forceinline__ void mem_unit(const Params& P, LAS unsigned char* lds, int b, int hm, int qt0) {
    const int tid = threadIdx.x, lane = tid & 63, w = tid >> 6, ql = lane & 31, hi = lane >> 5;
    const bf16_t* qm = (const bf16_t*)(P.ws + WS_QM); const bf16_t* memk = (const bf16_t*)(P.ws + WS_MEMK); const bf16_t* memvT = (const bf16_t*)(P.ws + WS_MEMVT);
    bf16_t* ymem = (bf16_t*)P.out + (size_t)T_TOK * 1024;
    LAS unsigned char* Km = lds; LAS unsigned char* Vm = lds + MEM_VOFF;
    __syncthreads();
#pragma unroll
    for (int i = 0; i < 8; ++i) { const int p = tid + 512 * i, row = p >> 4, c = p & 15;
        f32x4 f0, f1; unpack8(*(const u32x4*)(memk + ((size_t)b * 256 + row) * 512 + hm * 128 + c * 8), f0, f1);
        const f32x4 q0 = f0 * f0, q1 = f1 * f1; float ss = ((q0[0] + q0[1]) + (q0[2] + q0[3])) + ((q1[0] + q1[1]) + (q1[2] + q1[3]));
        ss += __shfl_xor(ss, 1); ss += __shfl_xor(ss, 2); ss += __shfl_xor(ss, 4); ss += __shfl_xor(ss, 8);
        const float rk = rsqrtf(ss * (1.0f / 128.0f) + EPS);
        const f32x4 g0 = *(const f32x4*)(P.memk_g + c * 8), g1 = *(const f32x4*)(P.memk_g + c * 8 + 4);
        *(LAS u32x4*)(Km + row * MEM_KS + c * 16) = pack8(f0 * rk * g0, f1 * rk * g1); }
#pragma unroll
    for (int i = 0; i < 8; ++i) { const int p = tid + 512 * i, d = p >> 5, c = p & 31;
        const u32x4 v = *(const u32x4*)(memvT + ((size_t)(b * 4 + hm) * 128 + d) * 256 + c * 8);
        LAS unsigned char* vp = Vm + d * MEM_VS + c * 16; *(LAS u32x2*)vp = (u32x2){v.x, v.y}; *(LAS u32x2*)(vp + 8) = (u32x2){v.z, v.w}; }
    __syncthreads();
    for (int qt = qt0; qt < qt0 + 4; ++qt) {
        const size_t tq = (size_t)b * SEQ + 256 * qt + 32 * w + ql;
        bf16x8 qf[8];
        { f32x4 f[8][2]; float ss = 0.f;
#pragma unroll
            for (int ks = 0; ks < 8; ++ks) { unpack8(*(const u32x4*)(qm + tq * 512 + hm * 128 + 16 * ks + 8 * hi), f[ks][0], f[ks][1]);
                const f32x4 q0 = f[ks][0] * f[ks][0], q1 = f[ks][1] * f[ks][1]; ss += ((q0[0] + q0[1]) + (q0[2] + q0[3])) + ((q1[0] + q1[1]) + (q1[2] + q1[3])); }
            ss += __shfl_xor(ss, 32);
            const float rq = rsqrtf(ss * (1.0f / 128.0f) + EPS) * C2_MEM;
#pragma unroll
            for (int ks = 0; ks < 8; ++ks) { const f32x4 g0 = *(const f32x4*)(P.memq_g + 16 * ks + 8 * hi), g1 = *(const f32x4*)(P.memq_g + 16 * ks + 8 * hi + 4);
                const u32x4 pk = pack8(f[ks][0] * rq * g0, f[ks][1] * rq * g1); qf[ks] = __builtin_bit_cast(bf16x8, pk); } }
        f32x16 o[4];
#pragma unroll
        for (int d = 0; d < 4; ++d)
#pragma unroll
            for (int i = 0; i < 16; ++i) o[d][i] = 0.f;
        float lsum = 0.f;
        for (int kt = 0; kt < 8; ++kt) {
            f32x16 s;
#pragma unroll
            for (int i = 0; i < 16; ++i) s[i] = 0.f;
            const LAS unsigned char* kp = Km + (32 * kt + ql) * MEM_KS + 16 * hi;
#pragma unroll
            for (int ks = 0; ks < 8; ++ks) s = MFMA32(*(const LAS bf16x8*)(kp + 32 * ks), qf[ks], s);
            float pe[16];
#pragma unroll
            for (int i = 0; i < 16; ++i) { pe[i] = __builtin_amdgcn_exp2f(s[i]); lsum += pe[i]; }
            u32x4 pa0, pa1;
            pa0.x = cvt_pk_bf16_t(pe[0], pe[1]); pa0.y = cvt_pk_bf16_t(pe[2], pe[3]); pa0.z = cvt_pk_bf16_t(pe[4], pe[5]); pa0.w = cvt_pk_bf16_t(pe[6], pe[7]);
            pa1.x = cvt_pk_bf16_t(pe[8], pe[9]); pa1.y = cvt_pk_bf16_t(pe[10], pe[11]); pa1.z = cvt_pk_bf16_t(pe[12], pe[13]); pa1.w = cvt_pk_bf16_t(pe[14], pe[15]);
            const LAS unsigned char* vp = Vm + ql * MEM_VS + (32 * kt + 4 * hi) * 2;
#pragma unroll
            for (int kf = 0; kf < 2; ++kf) { const bf16x8 pb = __builtin_bit_cast(bf16x8, kf ? pa1 : pa0);
#pragma unroll
                for (int d = 0; d < 4; ++d) { const u32x2 lo = *(const LAS u32x2*)(vp + 32 * d * MEM_VS + 32 * kf), h8 = *(const LAS u32x2*)(vp + 32 * d * MEM_VS + 32 * kf + 16);
                    const u32x4 a = (u32x4){lo.x, lo.y, h8.x, h8.y}; o[d] = MFMA32(__builtin_bit_cast(bf16x8, a), pb, o[d]); } }
        }
        lsum += __shfl_xor(lsum, 32);
        const float inv = 1.0f / lsum;
        bf16_t* yp = ymem + tq * 512 + hm * 128 + 4 * hi;
#pragma unroll
        for (int d = 0; d < 4; ++d)
#pragma unroll
            for (int g4 = 0; g4 < 4; ++g4)
                *(u32x2*)(yp + 32 * d + 8 * g4) = (u32x2){cvt_pk_bf16(o[d][4 * g4] * inv, o[d][4 * g4 + 1] * inv), cvt_pk_bf16(o[d][4 * g4 + 2] * inv, o[d][4 * g4 + 3] * inv)};
    }
}

__device__ __forceinline__ void conv_slice(const Params& P, int slice) {
    const bf16_t* cv = (const bf16_t*)(P.ws + WS_CONV); bf16_t* yc = (bf16_t*)P.out;
    const int tid = threadIdx.x;
    for (int i = 0; i < 4; ++i) { const int item = tid + 512 * i, cgp = item & 63, rg = item >> 6; const int t0 = slice * 256 + 8 * rg, c = 8 * cgp;
        f32x4 w0[2], w1[2], w2[2], bi[2];
#pragma unroll
        for (int k = 0; k < 2; ++k) { w0[k] = *(const f32x4*)(P.conv_w + c + 4 * k); w1[k] = *(const f32x4*)(P.conv_w + 512 + c + 4 * k); w2[k] = *(const f32x4*)(P.conv_w + 1024 + c + 4 * k); bi[k] = *(const f32x4*)(P.conv_b + c + 4 * k); }
        const bool first = (t0 & (SEQ - 1)) == 0;
        u32x4 rc[10], rx[10], rb[8];
#pragma unroll
        for (int r = 0; r < 10; ++r) { const size_t t = (size_t)(t0 - 2 + r);
            if (r >= 2 || !first) { rc[r] = *(const u32x4*)(cv + t * 1536 + 512 + c); rx[r] = *(const u32x4*)(cv + t * 1536 + 1024 + c); } else { rc[r] = (u32x4){0u, 0u, 0u, 0u}; rx[r] = rc[r]; }
            if (r >= 2) rb[r - 2] = *(const u32x4*)(cv + t * 1536 + c); }
        f32x4 m2[2], m1[2];
        { f32x4 a0, a1, b0, b1; unpack8(rc[0], a0, a1); unpack8(rx[0], b0, b1); m2[0] = a0 * b0; m2[1] = a1 * b1; unpack8(rc[1], a0, a1); unpack8(rx[1], b0, b1); m1[0] = a0 * b0; m1[1] = a1 * b1; }
#pragma unroll
        for (int r = 0; r < 8; ++r) { const size_t t = (size_t)(t0 + r); f32x4 a0, a1, b0, b1, g0, g1;
            unpack8(rc[r + 2], a0, a1); unpack8(rx[r + 2], b0, b1); unpack8(rb[r], g0, g1);
            const f32x4 m00 = a0 * b0, m01 = a1 * b1;
            const f32x4 y0 = g0 * (w0[0] * m2[0] + w1[0] * m1[0] + w2[0] * m00 + bi[0]), y1 = g1 * (w0[1] * m2[1] + w1[1] * m1[1] + w2[1] * m01 + bi[1]);
            *(u32x4*)(yc + t * 512 + c) = pack8(y0, y1);
            m2[0] = m1[0]; m2[1] = m1[1]; m1[0] = m00; m1[1] = m01; }
    }
}

__device__ __forceinline__ void phase_mixers(const Params& P, LAS unsigned char* lds) {
    if (P.sub & 1) for (int c = blockIdx.x; c < 256; c += gridDim.x) {
        const int bh = c >> 1, odd = c & 1;
        u32x4 kr[4], vr[4];
        for (int i = 0; i < 8; ++i) { const int e = 2 * (i >> 1); const int n = (i & 1) ? (15 - e - odd) : (e + odd);
            const int i2 = i + 1, e2 = 2 * (i2 >> 1); const int nn = i2 < 8 ? ((i2 & 1) ? (15 - e2 - odd) : (e2 + odd)) : -1;
            moba_unit(P, lds, bh >> 3, bh & 7, n, i == 0, nn, kr, vr); }
    }
    if (P.sub & 2) for (int c = blockIdx.x; c < 256; c += gridDim.x) mem_unit(P, lds, c >> 4, (c >> 2) & 3, (c & 3) * 4);
    if (P.sub & 4) for (int c = blockIdx.x; c < 256; c += gridDim.x) conv_slice(P, c);
}

__device__ __forceinline__ void phase_ffn_fix(const Params& P) {
    const float* halo = (const float*)(P.ws + WS_AR); bf16_t* u = (bf16_t*)(P.ws + WS_BU);
    constexpr int CG = DFF / 8;
    const int total = 1024 * 2 * CG;
    for (int idx = blockIdx.x * 512 + threadIdx.x; idx < total; idx += gridDim.x * 512) {
        const int cgp = idx % CG, rr = idx / CG, r = rr & 1, G = rr >> 1, c = cgp * 8;
        const bool seq0 = (G & 63) == 0;
        const float* hg = halo + (size_t)G * 6 * DFF + c; const float* hp = halo + (size_t)(G - 1) * 6 * DFF + c;
        f32x4 z[2];
#pragma unroll
        for (int k = 0; k < 2; ++k) {
            const f32x4 w0 = *(const f32x4*)(P.ffn_conv_w + c + 4 * k), w1 = *(const f32x4*)(P.ffn_conv_w + DFF + c + 4 * k), w2 = *(const f32x4*)(P.ffn_conv_w + 2 * DFF + c + 4 * k), bi = *(const f32x4*)(P.ffn_conv_b + c + 4 * k);
            const f32x4 zero = (f32x4){0.f, 0.f, 0.f, 0.f};
            const f32x4 a = *(const f32x4*)(hg + (size_t)(2 + r) * DFF + 4 * k), b = *(const f32x4*)(hg + (size_t)(4 + r) * DFF + 4 * k);
            f32x4 p1, p2;
            if (r == 0) { p1 = seq0 ? zero : *(const f32x4*)(hp + (size_t)1 * DFF + 4 * k); p2 = seq0 ? zero : *(const f32x4*)(hp + 4 * k); }
            else { p1 = *(const f32x4*)(hg + (size_t)2 * DFF + 4 * k); p2 = seq0 ? zero : *(const f32x4*)(hp + (size_t)1 * DFF + 4 * k); }
            f32x4 t = w0 * p2 + w1 * p1 + w2 * a + bi;
#pragma unroll
            for (int e = 0; e < 4; ++e) t[e] = t[e] * fast_sigmoid(t[e]) * b[e];
            z[k] = t; }
        *(u32x4*)(u + (size_t)(G * 64 + r) * DFF + c) = pack8(z[0], z[1]);
    }
}

#define XB_TMO      128
#define XB_XCNT(j)  (256  + 64 * (j))
#define XB_XSUB(j)  (1280 + 64 * (j))
#define XB_XGEN(j)  (2304 + 64 * (j))
#define XB_TOP      3328
#define XB_TOPGEN   3392
#define XCD_BAR_WORDS 3456
#define XB_SPIN_CAP (1u << 18)

__device__ __forceinline__ unsigned xb_ld(unsigned* p)              { return __hip_atomic_load(p, __ATOMIC_RELAXED, __HIP_MEMORY_SCOPE_AGENT); }
__device__ __forceinline__ unsigned xb_add(unsigned* p, unsigned v) { return __hip_atomic_fetch_add(p, v, __ATOMIC_RELAXED, __HIP_MEMORY_SCOPE_AGENT); }
__device__ __forceinline__ unsigned xb_xcc_id() { return (unsigned)__builtin_amdgcn_s_getreg((3 << 11) | 20) & 0xFu; }
#define XB_SPIN(cond, bar) do { unsigned _sp = 0; while (cond) { __builtin_amdgcn_s_sleep(1); \
    if ((++_sp & 255u) == 0u) { if (xb_ld(&(bar)[XB_TMO])) break; if (_sp > XB_SPIN_CAP) { atomicAdd(&(bar)[XB_TMO], 1u); break; } } } } while (0)

struct XcdBarrier {
    unsigned* bar; unsigned x;
    volatile LAS unsigned* st;
};

__device__ __forceinline__ XcdBarrier xcd_barrier_post(unsigned* bar, volatile LAS unsigned* st) {
    XcdBarrier b; b.bar = bar; b.x = xb_xcc_id(); b.st = st;
    if (threadIdx.x == 0) (void)xb_add(&bar[XB_XCNT(b.x)], 1u);
    return b;
}
__device__ __forceinline__ void xcd_barrier_complete(unsigned* bar, unsigned x, unsigned& nloc, unsigned& nx) {
    const unsigned G = gridDim.x;
    unsigned sum, cnt, mine, sp = 0u;
    for (;;) {
        sum = 0u; cnt = 0u; mine = 0u;
#pragma unroll
        for (unsigned j = 0; j < 16; ++j) { const unsigned c = xb_ld(&bar[XB_XCNT(j)]); sum += c; cnt += (c > 0u) ? 1u : 0u; mine = (j == x) ? c : mine; }
        if (sum == G) break;
        __builtin_amdgcn_s_sleep(1);
        if ((++sp & 255u) == 0u) { if (xb_ld(&bar[XB_TMO])) break; if (sp > XB_SPIN_CAP) { atomicAdd(&bar[XB_TMO], 1u); break; } }
    }
    nloc = mine > 0u ? mine : 1u; nx = cnt > 0u ? cnt : 1u;
}

__device__ __forceinline__ void xcd_barrier(const XcdBarrier& b) {
    asm volatile("s_waitcnt vmcnt(0)" ::: "memory");
    __syncthreads();
    if (threadIdx.x == 0) {
        unsigned* bar = b.bar;
        __builtin_amdgcn_s_waitcnt(0);
        unsigned nloc = b.st[0], nx = b.st[1];
        if (nloc == 0u) { xcd_barrier_complete(bar, b.x, nloc, nx); b.st[0] = nloc; b.st[1] = nx; }
        const unsigned old = xb_add(&bar[XB_XSUB(b.x)], 1u);
        const unsigned gen = old / nloc;
        if (old + 1u == (gen + 1u) * nloc) {
            __builtin_amdgcn_fence(__ATOMIC_RELEASE, "agent");
            asm volatile("s_waitcnt vmcnt(0)" ::: "memory");
            const unsigned og = xb_add(&bar[XB_TOP], 1u);
            const unsigned tg = og / nx;
            if (og + 1u == (tg + 1u) * nx) xb_add(&bar[XB_TOPGEN], 1u);
            else XB_SPIN(xb_ld(&bar[XB_TOPGEN]) == tg, bar);
            __builtin_amdgcn_fence(__ATOMIC_ACQUIRE, "agent");
            xb_add(&bar[XB_XGEN(b.x)], 1u);
            asm volatile("s_waitcnt vmcnt(0)" ::: "memory");
        } else {
            XB_SPIN(xb_ld(&bar[XB_XGEN(b.x)]) == gen, bar);
            __builtin_amdgcn_fence(__ATOMIC_ACQUIRE, "agent");
            asm volatile("s_waitcnt vmcnt(0)" ::: "memory");
        }
    }
    __syncthreads();
}

constexpr int NPHASE = 8;
__global__ void __launch_bounds__(512, 2) mk_fwd(Params P) {
    extern __shared__ __attribute__((aligned(16))) unsigned char lds_raw[];
    LAS unsigned char* lds = (LAS unsigned char*)lds_raw;
    cg::grid_group grid = cg::this_grid();
    unsigned char* ws = P.ws;
    const int G = gridDim.x, bx = blockIdx.x;
    const int lo = P.ph_lo, hi = P.ph_hi;
    volatile LAS unsigned* bst = (volatile LAS unsigned*)(lds + LDS_BARST);
    if (threadIdx.x < 2) bst[threadIdx.x] = 0u;
    __syncthreads();
#ifndef MK_RANGES
    (void)xcd_barrier_post((unsigned*)(ws + WS_BAR), bst);
    if (P.ph_lo < 0) grid.sync();
#endif
#ifndef SUBM
#define SUBM 31
#endif
#ifndef PH_MASK
#define PH_MASK 0xff
#endif
#define IN(k) (((PH_MASK >> (k)) & 1) && lo <= (k) && (k) < hi)
#ifdef MK_RANGES
#define SEAM(k) do { if (IN(k) && IN((k) + 1)) grid.sync(); } while (0)
#else
#define SEAM(k) do { if (IN(k) && IN((k) + 1)) { { XcdBarrier xb_; xb_.bar = (unsigned*)(ws + WS_BAR); xb_.x = xb_xcc_id(); xb_.st = (volatile LAS unsigned*)(lds + LDS_BARST); xcd_barrier(xb_); } } } while (0)
#endif
    if (IN(0)) { phase_prep(P, lds); __syncthreads(); }
    SEAM(0);
#ifdef EXTRA_SYNCS
    for (int i = 0; i < EXTRA_SYNCS; ++i) SEAM(0);
#endif
    if (IN(1)) {
        { pg8::GemmStd g{(const bf16_t*)P.out, (const bf16_t*)(ws + WS_W1T), 1024};
#define EPI_IN_ARGS (bf16_t*)(ws + WS_CONV), (bf16_t*)(ws + WS_QK), (bf16_t*)(ws + WS_VT), (bf16_t*)(ws + WS_QM), (bf16_t*)(ws + WS_GATES), P.b_gate, P.moba_qg, P.moba_kg, (float*)(ws + WS_KBAR)
          if (SUBM & 2) { SubOrder S; S.base.init(T_TOK, 4 * 256, G, bx); S.split = 4; S.off0 = 6; S.off1 = 0; EpiIn<1> E{EPI_IN_ARGS};
            pg8::gemm_phase<EpiIn<1>, SubOrder, pg8::GemmStd, true, true>(lds, g, S, E); }
          if (SUBM & 4) { pg8::GemmStd gv{(const bf16_t*)(ws + WS_W1T) + (size_t)2560 * 1024, (const bf16_t*)P.out, 1024};
            pg8::StaticOrder S; S.init(512, T_TOK, G, bx); EpiVT E{(bf16_t*)(ws + WS_VT)};
            pg8::gemm_phase<EpiVT, pg8::StaticOrder, pg8::GemmStd, true, true>(lds, gv, S, E); }
          if (SUBM & 1) { SubOrder S; S.base.init(T_TOK, 8 * 256, G, bx); S.split = 6; S.off0 = 0; S.off1 = 12; EpiIn<0> E{EPI_IN_ARGS};
            pg8::gemm_phase<EpiIn<0>, SubOrder, pg8::GemmStd, true, true>(lds, g, S, E); }
          if (SUBM & 8) { SubOrder S; S.base.init(T_TOK, 12 * 256, G, bx); S.split = 12; S.off0 = 14; S.off1 = 0; EpiIn<3> E{EPI_IN_ARGS};
            pg8::gemm_phase<EpiIn<3>, SubOrder, pg8::GemmStd, true, true>(lds, g, S, E); }
#undef EPI_IN_ARGS
        }
        if (SUBM & 16) { pg8::GemmStd g{(const bf16_t*)(ws + WS_MEMB), (const bf16_t*)(ws + WS_WKVT), 1024}; pg8::StaticOrder S; S.init(MEMT, 1024, G, bx);
          EpiMemKV E{(bf16_t*)(ws + WS_MEMK), (bf16_t*)(ws + WS_MEMVT)};
          pg8::gemm_phase<EpiMemKV, pg8::StaticOrder, pg8::GemmStd, true, true>(lds, g, S, E); }
    }
    SEAM(1);
    if (IN(2)) { phase_mixers(P, lds); __syncthreads(); }
    SEAM(2);
    if (IN(3)) {
        const bf16_t* y = (const bf16_t*)P.out;
        pg8::GemmSeg3 g{y, y + (size_t)T_TOK * 512, y + (size_t)T_TOK * 1024, (const bf16_t*)(ws + WS_WBRT), 512};
        SegOrder S; S.base.init(T_TOK, 1024, G, bx);
        EpiMerge E{(const bf16_t*)(ws + WS_GATES), (bf16_t*)(ws + WS_MERGED)};
        pg8::gemm_phase<EpiMerge, SegOrder, pg8::GemmSeg3, true, true>(lds, g, S, E);
    }
    SEAM(3);
    if (IN(4)) {
        pg8::GemmStd g{(const bf16_t*)(ws + WS_MERGED), (const bf16_t*)(ws + WS_WOT), 1024}; pg8::StaticOrder S; S.init(T_TOK, 1024, G, bx);
        EpiWo E{P.x, P.out, (bf16_t*)(ws + WS_X1B), (float*)(ws + WS_SSQ)};
        pg8::gemm_phase<EpiWo, pg8::StaticOrder, pg8::GemmStd, true, true>(lds, g, S, E);
    }
    SEAM(4);
    if (IN(5)) {
        pg8::GemmStd g{(const bf16_t*)(ws + WS_X1B), (const bf16_t*)(ws + WS_WUPT), 1024}; pg8::StaticOrder S; S.init(T_TOK, 2 * DFF, G, bx);
        EpiUp E{(const float*)(ws + WS_SSQ), (bf16_t*)(ws + WS_BU), (float*)(ws + WS_AR), P.ffn_conv_w, P.ffn_conv_b};
        pg8::gemm_phase<EpiUp, pg8::StaticOrder, pg8::GemmStd, true, true>(lds, g, S, E);
    }
    SEAM(5);
    if (IN(6)) phase_ffn_fix(P);
    SEAM(6);
    if (IN(7)) {
        pg8::GemmStd g{(const bf16_t*)(ws + WS_BU), (const bf16_t*)(ws + WS_WDNT), DFF}; pg8::StaticOrder S; S.init(T_TOK, 1024, G, bx);
        EpiDown E{P.out};
        pg8::gemm_phase<EpiDown, pg8::StaticOrder, pg8::GemmStd, true, true>(lds, g, S, E);
    }
#undef IN
#undef SEAM
}

#if defined(__HIP_DEVICE_COMPILE__)
#pragma clang attribute pop
#endif
extern "C" void kernel_launch(void* const* d_in, const int* in_sizes, int n_in, void* d_out, int out_size, void* d_ws, size_t ws_size, hipStream_t stream) {
    static int grid = 0;
    if (grid == 0) {
        if (n_in != 22 || in_sizes[0] != T_TOK * DM || out_size != T_TOK * DM || ws_size < WS_NEED) {
            fprintf(stderr, "kernel_launch: unexpected shapes: n_in %d in0 %d out %d ws %zu (need %zu)\n", n_in, n_in > 0 ? in_sizes[0] : -1, out_size, ws_size, (size_t)WS_NEED); grid = -1; return; }
        int dev = 0, cus = 0, per_cu = 0;
        (void)hipGetDevice(&dev); (void)hipDeviceGetAttribute(&cus, hipDeviceAttributeMultiprocessorCount, dev);
        if (hipFuncSetAttribute((const void*)mk_fwd, hipFuncAttributeMaxDynamicSharedMemorySize, LDS_BYTES) != hipSuccess) { fprintf(stderr, "kernel_launch: hipFuncSetAttribute failed\n"); grid = -1; return; }
        if (hipOccupancyMaxActiveBlocksPerMultiprocessor(&per_cu, (const void*)mk_fwd, 512, LDS_BYTES) != hipSuccess || per_cu < 1) { fprintf(stderr, "kernel_launch: occupancy query says %d\n", per_cu); per_cu = 1; }
        (void)hipGetLastError();
        grid = cus * per_cu;
    }
    if (grid < 0) return;
    if (hipMemsetAsync((char*)d_ws + WS_BAR, 0, 16384, stream) != hipSuccess) { fprintf(stderr, "kernel_launch: memset of the barrier words failed\n"); return; }
    Params p{};
    const float** pp = (const float**)&p;
    for (int i = 0; i < 22; ++i) pp[i] = (const float*)d_in[i];
    p.out = (float*)d_out; p.ws = (unsigned char*)d_ws;
#ifdef MK_RANGES
    { const int rg[][3] = MK_RANGES;
      for (unsigned k = 0; k < sizeof(rg) / sizeof(rg[0]); ++k) { p.ph_lo = rg[k][0]; p.ph_hi = rg[k][1]; p.sub = rg[k][2]; void* args[] = {&p};
        hipError_t e = hipLaunchCooperativeKernel((const void*)mk_fwd, dim3(grid), dim3(512), args, LDS_BYTES, stream);
        if (e != hipSuccess) { fprintf(stderr, "launch %u failed: %s\n", k, hipGetErrorString(e)); break; } } }
#else
    p.ph_lo = 0; p.ph_hi = NPHASE; p.sub = 7; void* args[] = {&p};
    hipError_t e = hipLaunchCooperativeKernel((const void*)mk_fwd, dim3(grid), dim3(512), args, LDS_BYTES, stream);
    if (e != hipSuccess) fprintf(stderr, "cooperative launch failed: %s (grid %d)\n", hipGetErrorString(e), grid);
#endif
}
```

```cpp
#if defined(__HIP_DEVICE_COMPILE__)
#pragma clang attribute push(__attribute__((target("no-packed-fp32-ops"))), apply_to = function)
#endif
#include <hip/hip_runtime.h>
#include <hip/hip_cooperative_groups.h>
#include <cstdio>
#include <cstdint>
namespace cg = cooperative_groups;

#define LAS __attribute__((address_space(3)))
typedef unsigned short bf16_t;
typedef short bf16x8 __attribute__((ext_vector_type(8)));
typedef float f32x4 __attribute__((ext_vector_type(4)));
typedef float f32x16 __attribute__((ext_vector_type(16)));
typedef unsigned u32x4 __attribute__((ext_vector_type(4)));
typedef unsigned u32x2 __attribute__((ext_vector_type(2)));
typedef float f32x2 __attribute__((ext_vector_type(2)));

constexpr int T_TOK = 65536, DM = 1024, SEQ = 4096, NBATCH = 16, NBLK = 16, INC = 6656, DFF = 2816, MEMT = 4096;
constexpr float EPS = 1e-6f;
constexpr float LOG2E = 1.4426950408889634f;
constexpr float C2_MOBA = 0.125f * LOG2E;
constexpr float C2_MEM = 0.08838834764831845f * LOG2E;

__device__ __forceinline__ unsigned cvt_pk_bf16(float lo, float hi) { unsigned r; asm volatile("v_cvt_pk_bf16_f32 %0, %1, %2" : "=v"(r) : "v"(lo), "v"(hi)); return r; }
__device__ __forceinline__ unsigned cvt_pk_bf16_t(float lo, float hi) { unsigned r; asm volatile("s_nop 1\n\tv_cvt_pk_bf16_f32 %0, %1, %2" : "=v"(r) : "v"(lo), "v"(hi)); return r; }
__device__ __forceinline__ float bf_lo(unsigned w) { return __uint_as_float(w << 16); }
__device__ __forceinline__ float bf_hi(unsigned w) { return __uint_as_float(w & 0xffff0000u); }
__device__ __forceinline__ u32x4 pack8(f32x4 a, f32x4 b) { u32x4 w; w.x = cvt_pk_bf16(a[0], a[1]); w.y = cvt_pk_bf16(a[2], a[3]); w.z = cvt_pk_bf16(b[0], b[1]); w.w = cvt_pk_bf16(b[2], b[3]); return w; }
__device__ __forceinline__ u32x4 pack8t(f32x4 a, f32x4 b) { u32x4 w; w.x = cvt_pk_bf16_t(a[0], a[1]); w.y = cvt_pk_bf16_t(a[2], a[3]); w.z = cvt_pk_bf16_t(b[0], b[1]); w.w = cvt_pk_bf16_t(b[2], b[3]); return w; }
__device__ __forceinline__ void unpack8(u32x4 w, f32x4& a, f32x4& b) { a = (f32x4){bf_lo(w.x), bf_hi(w.x), bf_lo(w.y), bf_hi(w.y)}; b = (f32x4){bf_lo(w.z), bf_hi(w.z), bf_lo(w.w), bf_hi(w.w)}; }
__device__ __forceinline__ float fast_sigmoid(float x) { return __builtin_amdgcn_rcpf(1.0f + __builtin_amdgcn_exp2f(x * -LOG2E)); }

struct Params {
    const float* x; const float* mem; const float* g_mix; const float* w_in; const float* b_gate; const float* conv_w; const float* conv_b;
    const float* moba_qg; const float* moba_kg; const float* g_mem; const float* w_mem_kv; const float* memq_g; const float* memk_g;
    const float* w_br_conv; const float* w_br_moba; const float* w_br_mem; const float* w_o; const float* g_ffn; const float* w_up;
    const float* ffn_conv_w; const float* ffn_conv_b; const float* w_down;
    float* out; unsigned char* ws;
    int ph_lo, ph_hi, sub, pad;
};

constexpr size_t MiB = 1u << 20;
constexpr size_t WS_KBAR = 0;
constexpr size_t WS_BAR = 768 * 1024;
constexpr size_t WS_SSQ = 1 * MiB;
constexpr size_t WS_W1T = 5 * MiB;
constexpr size_t WS_WKVT = 18 * MiB;
constexpr size_t WS_WBRT = 20 * MiB;
constexpr size_t WS_WOT = 23 * MiB;
constexpr size_t WS_WUPT = 25 * MiB;
constexpr size_t WS_WDNT = 36 * MiB;
constexpr size_t WS_MEMB = 42 * MiB;
constexpr size_t WS_MEMK = 50 * MiB;
constexpr size_t WS_MEMVT = 54 * MiB;
constexpr size_t WS_VT = 64 * MiB;
constexpr size_t WS_CONV = 128 * MiB;
constexpr size_t WS_QK = 320 * MiB;
constexpr size_t WS_QM = 448 * MiB;
constexpr size_t WS_GATES = 512 * MiB;
constexpr size_t WS_MERGED = 64 * MiB;
constexpr size_t WS_X1B = 192 * MiB;
constexpr size_t WS_AR = 320 * MiB;
constexpr size_t WS_BU = 672 * MiB;
constexpr size_t WS_NEED = 1024 * MiB;

constexpr int LDS_BYTES = 147456;
constexpr int LDS_BARST = LDS_BYTES - 64;

namespace pg8 {
#define PG8_LAS __attribute__((address_space(3)))
constexpr int BM = 256, BK = 64, HALF = 128, HTB = HALF * BK * 2  , STAGE_BYTES = 8 * HTB, NXCD = 8, WGM = 8;

__host__ __device__ __forceinline__ int lds_byte(int r, int c) { const int st = (r >> 4) * 2 + (c >> 5), rr = r & 15, cc = c & 31, ob = rr * 64 + cc * 2; return st * 1024 + (ob ^ (((ob >> 9) & 1) << 5)); }
__host__ __device__ __forceinline__ void stage_rc(int b, int& R, int& C) { const int st = b / 1024, sb = b % 1024, swz = sb ^ (((sb >> 9) & 1) << 5); R = (st >> 1) * 16 + swz / 64; C = (st & 1) * 32 + (swz % 64) / 2; }
__host__ __device__ __forceinline__ int perm32(int rho) { const int n = rho >> 4, i = rho & 15; return 8 * (i >> 2) + 4 * n + (i & 3); }

struct Unit { int pm, pn, seg; };
struct GemmStd { const bf16_t* A; const bf16_t* Bt; int K;
    __device__ __forceinline__ const char* a_ptr(const Unit& u) const { return (const char*)A + (size_t)u.pm * 512 * K; }
    __device__ __forceinline__ const char* b_ptr(const Unit& u) const { return (const char*)Bt + (size_t)u.pn * 512 * K; } };
struct GemmSeg3 { const bf16_t* A0; const bf16_t* A1; const bf16_t* A2; const bf16_t* Bt; int K;
    __device__ __forceinline__ const char* a_ptr(const Unit& u) const { const bf16_t* a = u.seg == 0 ? A0 : (u.seg == 1 ? A1 : A2); return (const char*)a + (size_t)u.pm * 512 * K; }
    __device__ __forceinline__ const char* b_ptr(const Unit& u) const { return (const char*)Bt + (size_t)u.seg * 1024 * K * 2 + (size_t)u.pn * 512 * K; } };

struct StaticOrder {
    int nM, nN, nwg, G, c;
    __host__ __device__ void init(int M, int N, int G_, int c_) { nM = M / BM; nN = N / BM; nwg = nM * nN; G = G_; c = c_; }
    __host__ __device__ bool next(int i, Unit& u) const {
        const long L = (long)i * G + c; if (L >= nwg) return false;
        int wgid = (int)L; { const int q = nwg / NXCD, r = nwg % NXCD, xcd = wgid % NXCD, off = wgid / NXCD; wgid = (xcd < r ? xcd * (q + 1) : r * (q + 1) + (xcd - r) * q) + off; }
        const int nig = WGM * nN, gid = wgid / nig, fm = gid * WGM, gsz = (nM - fm) < WGM ? (nM - fm) : WGM;
        u.pm = fm + ((wgid % nig) % gsz); u.pn = (wgid % nig) / gsz; u.seg = 0; return true;
    }
    __device__ __forceinline__ void a_ready(const Unit&) const {}
    __device__ __forceinline__ void done(const Unit&) const {}
};

template <class Epi, class Sched, class GemmT, bool ALIGN_EPI = false, bool SP2 = false>
__device__ __forceinline__ void gemm_phase(PG8_LAS unsigned char* lds, const GemmT g, const Sched& S, const Epi& E) {
    int tid = threadIdx.x; asm volatile("" : "+v"(tid));
    const int wid = __builtin_amdgcn_readfirstlane(tid >> 6), lane = tid & 63, wr = wid >> 2, wc = wid & 3, fr = lane & 15, fq = lane >> 4;
    const int K = g.K, nt = K / BK;
    unsigned voffA[2], voffB[2];
#pragma unroll
    for (int i = 0; i < 2; ++i) { int R, C; stage_rc(tid * 16 + i * 8192, R, C); const int Rb = Epi::PERM ? ((R & ~31) + perm32(R & 31)) : R;
        voffA[i] = (unsigned)(R * K + C) * 2u; voffB[i] = (unsigned)(Rb * K + C) * 2u; }
    const size_t kstep = (size_t)(BK * 2);
    const size_t hstep = (size_t)HALF * K * 2;

    const unsigned ldsw = (unsigned)wid * 1024u;
    const int aoff = lds_byte(wr * 64 + fr, fq * 8), boff = lds_byte(wc * 32 + fr, fq * 8);
#define PG8_SA(b, h) (((b) * 2 + (h)) * HTB)
#define PG8_SB(b, h) ((4 + (b) * 2 + (h)) * HTB)
#define PG8_STAGE(bufoff, gbase, voff) do { _Pragma("unroll") for (int _i = 0; _i < 2; ++_i) \
        __builtin_amdgcn_global_load_lds((const unsigned*)((const char*)(gbase) + (voff)[_i]), (PG8_LAS unsigned*)(lds + (bufoff) + ldsw + _i * 8192), 16, 0, 0); } while (0)
#define PG8_LDA(dst, b, h) do { _Pragma("unroll") for (int m = 0; m < 4; ++m) _Pragma("unroll") for (int k = 0; k < 2; ++k) dst[m][k] = *(const PG8_LAS bf16x8*)(lds + PG8_SA(b, h) + aoff + m * 2048 + k * 1024); } while (0)
#define PG8_LDB(dst, b, h) do { _Pragma("unroll") for (int n = 0; n < 2; ++n) _Pragma("unroll") for (int k = 0; k < 2; ++k) dst[n][k] = *(const PG8_LAS bf16x8*)(lds + PG8_SB(b, h) + boff + n * 2048 + k * 1024); } while (0)
#define PG8_MMA(ai, bj, At, Bt) do { __builtin_amdgcn_s_setprio(1); _Pragma("unroll") for (int m = 0; m < 4; ++m) _Pragma("unroll") for (int n = 0; n < 2; ++n) _Pragma("unroll") for (int k = 0; k < 2; ++k) \
        acc[ai][bj][m][n] = __builtin_amdgcn_mfma_f32_16x16x32_bf16(Bt[n][k], At[m][k], acc[ai][bj][m][n], 0, 0, 0); __builtin_amdgcn_s_setprio(0); } while (0)
#define PG8_WAIT_V(n) asm volatile("s_waitcnt vmcnt(" #n ")" ::: "memory")
#define PG8_WAIT_L(n) asm volatile("s_waitcnt lgkmcnt(" #n ")" ::: "memory")
#define PG8_BAR __builtin_amdgcn_s_barrier()
#define PG8_SCHED __builtin_amdgcn_sched_barrier(0)
    Unit cur, nxt; int ui = 0;
    if (!S.next(0, cur)) return;
    f32x4 acc[2][2][4][2];
#pragma unroll
    for (int a = 0; a < 2; ++a)
#pragma unroll
        for (int b = 0; b < 2; ++b)
#pragma unroll
            for (int m = 0; m < 4; ++m)
#pragma unroll
                for (int n = 0; n < 2; ++n) acc[a][b][m][n] = (f32x4){0.f, 0.f, 0.f, 0.f};
    bf16x8 At[4][2], B0[2][2], B1[2][2];
    const char* cA = g.a_ptr(cur); const char* cB = g.b_ptr(cur);
    S.a_ready(cur);
    if constexpr (SP2) {
        PG8_STAGE(PG8_SB(0, 0), cB, voffB); PG8_STAGE(PG8_SB(0, 1), cB + hstep, voffB); PG8_STAGE(PG8_SA(0, 0), cA, voffA); PG8_STAGE(PG8_SA(0, 1), cA + hstep, voffA);
        if (wr == 1) PG8_BAR;
        PG8_WAIT_V(2); PG8_BAR;
        PG8_STAGE(PG8_SB(1, 0), cB + kstep, voffB); PG8_STAGE(PG8_SA(1, 0), cA + kstep, voffA); PG8_STAGE(PG8_SB(1, 1), cB + hstep + kstep, voffB);
        PG8_WAIT_V(6); PG8_BAR;
    } else {
        PG8_STAGE(PG8_SB(0, 0), cB, voffB); PG8_STAGE(PG8_SA(0, 0), cA, voffA); PG8_STAGE(PG8_SB(0, 1), cB + hstep, voffB); PG8_STAGE(PG8_SA(0, 1), cA + hstep, voffA);
        if (wr == 1) PG8_BAR;
        PG8_WAIT_V(4); PG8_BAR;
        PG8_STAGE(PG8_SB(1, 0), cB + kstep, voffB); PG8_STAGE(PG8_SA(1, 0), cA + kstep, voffA); PG8_STAGE(PG8_SB(1, 1), cB + hstep + kstep, voffB);
        PG8_WAIT_V(6); PG8_BAR;
    }
    for (;;) {
        const bool has_next = S.next(ui + 1, nxt);
        const char* nA = has_next ? g.a_ptr(nxt) : cA; const char* nB = has_next ? g.b_ptr(nxt) : cB;
        for (int t = 0; t < nt; t += 2) {
            const bool last = (t == nt - 2);
            const char* a1 = cA + (size_t)(t + 1) * kstep;
            const char* a2 = last ? nA : cA + (size_t)(t + 2) * kstep; const char* b2 = last ? nB : cB + (size_t)(t + 2) * kstep;
            const char* a3 = a2 + kstep; const char* b3 = b2 + kstep;
            if (last && has_next) S.a_ready(nxt);
            if constexpr (SP2) {
            PG8_LDB(B0, 0, 0); PG8_LDB(B1, 0, 1); PG8_SCHED; PG8_LDA(At, 0, 0); PG8_STAGE(PG8_SA(1, 1), a1 + hstep, voffA);
            PG8_WAIT_V(8); PG8_WAIT_L(0); PG8_BAR; PG8_MMA(0, 0, At, B0); PG8_MMA(0, 1, At, B1); PG8_BAR; PG8_SCHED;
            PG8_LDA(At, 0, 1); PG8_STAGE(PG8_SB(0, 0), b2, voffB); PG8_STAGE(PG8_SB(0, 1), b2 + hstep, voffB); PG8_STAGE(PG8_SA(0, 0), a2, voffA);
            PG8_WAIT_V(8); PG8_WAIT_L(0); PG8_BAR; PG8_MMA(1, 0, At, B0); PG8_MMA(1, 1, At, B1); PG8_BAR; PG8_SCHED;
            PG8_LDB(B0, 1, 0); PG8_LDB(B1, 1, 1); PG8_SCHED; PG8_LDA(At, 1, 0); PG8_STAGE(PG8_SA(0, 1), a2 + hstep, voffA);
            PG8_WAIT_V(8); PG8_WAIT_L(0); PG8_BAR; PG8_MMA(0, 0, At, B0); PG8_MMA(0, 1, At, B1); PG8_BAR; PG8_SCHED;
            PG8_LDA(At, 1, 1); PG8_STAGE(PG8_SB(1, 0), b3, voffB); PG8_STAGE(PG8_SB(1, 1), b3 + hstep, voffB); PG8_STAGE(PG8_SA(1, 0), a3, voffA);
            PG8_WAIT_V(8); PG8_WAIT_L(0); PG8_BAR; PG8_MMA(1, 0, At, B0); PG8_MMA(1, 1, At, B1); PG8_BAR; PG8_SCHED;
            } else {
            PG8_LDB(B0, 0, 0); PG8_SCHED; PG8_LDA(At, 0, 0); PG8_STAGE(PG8_SA(1, 1), a1 + hstep, voffA);
            PG8_WAIT_L(8); PG8_BAR; PG8_WAIT_L(0); PG8_MMA(0, 0, At, B0); PG8_BAR; PG8_SCHED;
            PG8_LDB(B1, 0, 1); PG8_STAGE(PG8_SB(0, 0), b2, voffB);
            PG8_BAR; PG8_WAIT_L(0); PG8_MMA(0, 1, At, B1); PG8_BAR;
            PG8_LDA(At, 0, 1); PG8_STAGE(PG8_SA(0, 0), a2, voffA);
            PG8_BAR; PG8_WAIT_L(0); PG8_MMA(1, 0, At, B0); PG8_BAR; PG8_SCHED;
            PG8_STAGE(PG8_SB(0, 1), b2 + hstep, voffB);
            PG8_WAIT_V(6); PG8_BAR; PG8_MMA(1, 1, At, B1); PG8_BAR;
            PG8_LDB(B0, 1, 0); PG8_SCHED; PG8_LDA(At, 1, 0); PG8_STAGE(PG8_SA(0, 1), a2 + hstep, voffA);
            PG8_WAIT_L(8); PG8_BAR; PG8_WAIT_L(0); PG8_MMA(0, 0, At, B0); PG8_BAR; PG8_SCHED;
            PG8_LDB(B1, 1, 1); PG8_STAGE(PG8_SB(1, 0), b3, voffB);
            PG8_BAR; PG8_WAIT_L(0); PG8_MMA(0, 1, At, B1); PG8_BAR;
            PG8_LDA(At, 1, 1); PG8_STAGE(PG8_SA(1, 0), a3, voffA);
            PG8_BAR; PG8_WAIT_L(0); PG8_MMA(1, 0, At, B0); PG8_BAR; PG8_SCHED;
            PG8_STAGE(PG8_SB(1, 1), b3 + hstep, voffB);
            PG8_WAIT_V(6); PG8_BAR; PG8_MMA(1, 1, At, B1); PG8_BAR;
            }
        }
        if constexpr (ALIGN_EPI) { if (wr == 0) PG8_BAR; }
        if constexpr (!Epi::AFTER_DRAIN) { E(acc, cur, wr, wc, fr, fq); S.done(cur); }
        if (!has_next) break;
        if (Epi::zero_after(cur))
#pragma unroll
        for (int a = 0; a < 2; ++a)
#pragma unroll
            for (int b = 0; b < 2; ++b)
#pragma unroll
                for (int m = 0; m < 4; ++m)
#pragma unroll
                    for (int n = 0; n < 2; ++n) acc[a][b][m][n] = (f32x4){0.f, 0.f, 0.f, 0.f};
        cur = nxt; cA = nA; cB = nB; ++ui;
        if constexpr (ALIGN_EPI) { if (wr == 1) PG8_BAR; }
    }
    PG8_WAIT_V(0);
    if constexpr (!ALIGN_EPI) { if (wr == 0) PG8_BAR; }
    PG8_BAR;
    if constexpr (Epi::AFTER_DRAIN) { E.fused(acc, cur, wr, wc, fr, fq, lds, wid, lane); S.done(cur); }
#undef PG8_SA
#undef PG8_SB
#undef PG8_STAGE
#undef PG8_LDA
#undef PG8_LDB
#undef PG8_MMA
#undef PG8_WAIT_V
#undef PG8_WAIT_L
#undef PG8_BAR
#undef PG8_SCHED
}
}

using pg8::Unit;
struct SegOrder {
    pg8::StaticOrder base;
    __device__ bool next(int i, Unit& u) const { const int q = i / 3; if (!base.next(q, u)) return false; u.seg = i - 3 * q; return true; }
    __device__ __forceinline__ void a_ready(const Unit&) const {}
    __device__ __forceinline__ void done(const Unit&) const {}
};

struct SubOrder {
    pg8::StaticOrder base; int split, off0, off1;
    __device__ bool next(int i, Unit& u) const { if (!base.next(i, u)) return false; u.pn = u.pn < split ? off0 + u.pn : off1 + (u.pn - split); return true; }
    __device__ __forceinline__ void a_ready(const Unit&) const {}
    __device__ __forceinline__ void done(const Unit&) const {}
};

#define ACC_T f32x4 (&acc)[2][2][4][2]

template <int KIND  > struct EpiIn {
    static constexpr bool PERM = true, AFTER_DRAIN = false;
    static __device__ __forceinline__ bool zero_after(const Unit&) { return true; }
    bf16_t* convb; bf16_t* qk; bf16_t* vT; bf16_t* qm; bf16_t* gates; const float* bgate; const float* qg; const float* kg; float* kbar;
    __device__ __forceinline__ void operator()(ACC_T, const Unit& u, int wr, int wc, int fr, int fq) const {
        const int pn = u.pn;
        const int lc = 64 * wc + 8 * fq;
        const int row0 = u.pm * 256 + wr * 64 + fr;
        if constexpr (KIND == 0) {
            bf16_t* base; int ld, c0;
            asm volatile("" ::: "memory");
            if (pn < 6) { base = convb; ld = 1536; c0 = pn * 256; } else { base = qm; ld = 512; c0 = (pn - 12) * 256; }
#pragma unroll
            for (int ai = 0; ai < 2; ++ai)
#pragma unroll
                for (int m = 0; m < 4; ++m) { const int row = row0 + ai * 128 + m * 16;
#pragma unroll
                    for (int bj = 0; bj < 2; ++bj) *(u32x4*)(base + (size_t)row * ld + c0 + lc + 32 * bj) = pack8(acc[ai][bj][m][0], acc[ai][bj][m][1]); }
        } else if constexpr (KIND == 1) {
            asm volatile("" ::: "memory");
            const bool isk = pn >= 8; const int hl = (pn & 1) * 4 + wc;
            const float* gp = isk ? kg : qg; const float gs = isk ? 1.0f : C2_MOBA;
#pragma unroll
            for (int ai = 0; ai < 2; ++ai)
#pragma unroll
                for (int m = 0; m < 4; ++m) { const int row = row0 + ai * 128 + m * 16;
                    float ss = 0.f;
#pragma unroll
                    for (int bj = 0; bj < 2; ++bj)
#pragma unroll
                        for (int n = 0; n < 2; ++n) { const f32x4 q = acc[ai][bj][m][n] * acc[ai][bj][m][n]; ss += (q[0] + q[1]) + (q[2] + q[3]); }
                    ss += __shfl_xor(ss, 16); ss += __shfl_xor(ss, 32);
                    const float r = rsqrtf(ss * (1.0f / 64.0f) + EPS) * gs;
#pragma unroll
                    for (int bj = 0; bj < 2; ++bj) { asm volatile("" ::: "memory"); const f32x4 g0 = *(const f32x4*)(gp + 32 * bj + 8 * fq), g1 = *(const f32x4*)(gp + 32 * bj + 8 * fq + 4);
                        acc[ai][bj][m][0] = acc[ai][bj][m][0] * r * g0; acc[ai][bj][m][1] = acc[ai][bj][m][1] * r * g1;
                        *(u32x4*)(qk + (size_t)row * 1024 + (isk ? 512 : 0) + hl * 64 + 32 * bj + 8 * fq) = pack8(acc[ai][bj][m][0], acc[ai][bj][m][1]); }
                    __builtin_amdgcn_sched_barrier(0);
                }
            if (isk) {
#pragma unroll
                for (int bj = 0; bj < 2; ++bj)
#pragma unroll
                    for (int n = 0; n < 2; ++n) { f32x4 c4 = acc[0][bj][0][n];
#pragma unroll
                        for (int ai = 0; ai < 2; ++ai)
#pragma unroll
                            for (int m = 0; m < 4; ++m) if (ai + m > 0) c4 = c4 + acc[ai][bj][m][n];
#pragma unroll
                        for (int e = 0; e < 4; ++e) { float sm = c4[e]; sm += __shfl_xor(sm, 1); sm += __shfl_xor(sm, 2); sm += __shfl_xor(sm, 4); sm += __shfl_xor(sm, 8);
                            if (fr == 0) atomicAdd(kbar + ((size_t)((u.pm >> 4) * 8 + hl) * 16 + (u.pm & 15)) * 64 + 32 * bj + 8 * fq + 4 * n + e, sm); } }
            }
        } else if constexpr (KIND == 2) {
            asm volatile("" ::: "memory");
            const int hl = (pn & 1) * 4 + wc; const int b = u.pm >> 4; const int s0 = (u.pm & 15) * 256 + wr * 64 + fr;
            bf16_t* vb = vT + ((size_t)(b * 8 + hl) * 64 + 8 * fq) * 4096 + s0;
#pragma unroll
            for (int ai = 0; ai < 2; ++ai)
#pragma unroll
                for (int m = 0; m < 4; ++m) {
#pragma unroll
                    for (int bj = 0; bj < 2; ++bj)
#pragma unroll
                        for (int n = 0; n < 2; ++n) { const f32x4 v = acc[ai][bj][m][n]; const unsigned w0 = cvt_pk_bf16(v[0], v[1]), w1 = cvt_pk_bf16(v[2], v[3]);
                            bf16_t* p = vb + (size_t)(32 * bj + 4 * n) * 4096 + ai * 128 + m * 16;
                            p[0] = (bf16_t)(w0 & 0xffffu); p[4096] = (bf16_t)(w0 >> 16); p[2 * 4096] = (bf16_t)(w1 & 0xffffu); p[3 * 4096] = (bf16_t)(w1 >> 16); }
                }
        } else {
            asm volatile("" ::: "memory");
            const int gc = (pn - 14) * 256 + lc;
            f32x4 bb[2][2];
#pragma unroll
            for (int bj = 0; bj < 2; ++bj)
#pragma unroll
                for (int n = 0; n < 2; ++n) bb[bj][n] = *(const f32x4*)(bgate + gc + 32 * bj + 4 * n);
#pragma unroll
            for (int ai = 0; ai < 2; ++ai)
#pragma unroll
                for (int m = 0; m < 4; ++m) { const int row = row0 + ai * 128 + m * 16;
#pragma unroll
                    for (int bj = 0; bj < 2; ++bj) { f32x4 v0 = acc[ai][bj][m][0] + bb[bj][0], v1 = acc[ai][bj][m][1] + bb[bj][1];
#pragma unroll
                        for (int e = 0; e < 4; ++e) { v0[e] = fast_sigmoid(v0[e]); v1[e] = fast_sigmoid(v1[e]); }
                        *(u32x4*)(gates + (size_t)row * 3072 + gc + 32 * bj) = pack8t(v0, v1); }
                }
        }
    }
};

struct EpiVT {
    static constexpr bool PERM = true, AFTER_DRAIN = false;
    static __device__ __forceinline__ bool zero_after(const Unit&) { return true; }
    bf16_t* vT;
    __device__ __forceinline__ void operator()(ACC_T, const Unit& u, int wr, int wc, int fr, int fq) const {
        const int tok0 = u.pn * 256 + 32 * wc + 8 * fq;
        const int b = u.pn >> 4, s0 = tok0 & (SEQ - 1);
#pragma unroll
        for (int ai = 0; ai < 2; ++ai)
#pragma unroll
            for (int m = 0; m < 4; ++m) { const int rl = 128 * ai + 64 * wr + 16 * m + fr;
                const int dorig = 64 * ((rl & 127) >> 5) + 32 * (rl >> 7) + (rl & 31);
                const int h = u.pm * 4 + (dorig >> 6), d = dorig & 63;
                bf16_t* p = vT + ((size_t)(b * 8 + h) * 64 + d) * 4096 + s0;
#pragma unroll
                for (int bj = 0; bj < 2; ++bj) *(u32x4*)(p + 128 * bj) = pack8(acc[ai][bj][m][0], acc[ai][bj][m][1]); }
    }
};

struct EpiMemKV {
    static constexpr bool PERM = true, AFTER_DRAIN = false;
    static __device__ __forceinline__ bool zero_after(const Unit&) { return true; }
    bf16_t* memk; bf16_t* memvT;
    __device__ __forceinline__ void operator()(ACC_T, const Unit& u, int wr, int wc, int fr, int fq) const {
        const int row0 = u.pm * 256 + wr * 64 + fr;
#pragma unroll
        for (int ai = 0; ai < 2; ++ai)
#pragma unroll
            for (int m = 0; m < 4; ++m) { const int row = row0 + ai * 128 + m * 16;
#pragma unroll
                for (int bj = 0; bj < 2; ++bj) { const int col = u.pn * 256 + 128 * bj + 32 * wc + 8 * fq;
                    if (u.pn < 2) *(u32x4*)(memk + (size_t)row * 512 + col) = pack8(acc[ai][bj][m][0], acc[ai][bj][m][1]);
                    else { const int c = col - 512, h = c >> 7, d = c & 127; bf16_t* p = memvT + ((size_t)(u.pm * 4 + h) * 128 + d) * 256 + (row & 255);
#pragma unroll
                        for (int n = 0; n < 2; ++n) { const f32x4 v = acc[ai][bj][m][n]; const unsigned w0 = cvt_pk_bf16(v[0], v[1]), w1 = cvt_pk_bf16(v[2], v[3]);
                            bf16_t* q = p + (4 * n) * 256; q[0] = (bf16_t)(w0 & 0xffffu); q[256] = (bf16_t)(w0 >> 16); q[512] = (bf16_t)(w1 & 0xffffu); q[768] = (bf16_t)(w1 >> 16); } }
                } }
    }
};

struct EpiMerge {
    static constexpr bool PERM = true, AFTER_DRAIN = false;
    static __device__ __forceinline__ bool zero_after(const Unit& u) { return u.seg == 2; }
    const bf16_t* gates; bf16_t* merged;
    __device__ __forceinline__ void operator()(ACC_T, const Unit& u, int wr, int wc, int fr, int fq) const {
        const int row0 = u.pm * 256 + wr * 64 + fr; const int seg = u.seg;
#pragma unroll
        for (int ai = 0; ai < 2; ++ai)
#pragma unroll
            for (int m = 0; m < 4; ++m) { const int row = row0 + ai * 128 + m * 16;
#pragma unroll
                for (int bj = 0; bj < 2; ++bj) { const int col = u.pn * 256 + 128 * bj + 32 * wc + 8 * fq;
                    const bf16_t* gp = gates + (size_t)row * 3072 + col;
                    f32x4 a0, a1; unpack8(*(const u32x4*)(gp + (seg == 0 ? 0 : (seg == 1 ? 1024 : 2048))), a0, a1);
                    if (seg < 2) { f32x4 d0, d1; unpack8(*(const u32x4*)(gp + (seg == 0 ? 1024 : 2048)), d0, d1);
#pragma unroll
                        for (int e = 0; e < 4; ++e) { a0[e] = a0[e] * __builtin_amdgcn_rcpf(d0[e]); a1[e] = a1[e] * __builtin_amdgcn_rcpf(d1[e]); } }
                    acc[ai][bj][m][0] = acc[ai][bj][m][0] * a0; acc[ai][bj][m][1] = acc[ai][bj][m][1] * a1;
                    if (seg == 2) *(u32x4*)(merged + (size_t)row * 1024 + col) = pack8(acc[ai][bj][m][0], acc[ai][bj][m][1]);
                } }
    }
};

struct EpiWo {
    static constexpr bool PERM = true, AFTER_DRAIN = false;
    static __device__ __forceinline__ bool zero_after(const Unit&) { return true; }
    const float* x; float* out; bf16_t* x1b; float* ssq;
    __device__ __forceinline__ void operator()(ACC_T, const Unit& u, int wr, int wc, int fr, int fq) const {
        const int row0 = u.pm * 256 + wr * 64 + fr;
#pragma unroll
        for (int ai = 0; ai < 2; ++ai)
#pragma unroll
            for (int m = 0; m < 4; ++m) { const int row = row0 + ai * 128 + m * 16; float ss = 0.f;
#pragma unroll
                for (int bj = 0; bj < 2; ++bj) { const size_t o = (size_t)row * 1024 + u.pn * 256 + 128 * bj + 32 * wc + 8 * fq;
                    const f32x4 v0 = *(const f32x4*)(x + o) + acc[ai][bj][m][0], v1 = *(const f32x4*)(x + o + 4) + acc[ai][bj][m][1];
                    *(f32x4*)(out + o) = v0; *(f32x4*)(out + o + 4) = v1; *(u32x4*)(x1b + o) = pack8(v0, v1);
                    const f32x4 q0 = v0 * v0, q1 = v1 * v1; ss += ((q0[0] + q0[1]) + (q0[2] + q0[3])) + ((q1[0] + q1[1]) + (q1[2] + q1[3])); }
                ss += __shfl_xor(ss, 16); ss += __shfl_xor(ss, 32);
                if (fq == 0) ssq[(size_t)row * 16 + u.pn * 4 + wc] = ss; }
    }
};

template <int CTRL> __device__ __forceinline__ f32x4 dpp4(f32x4 v) { f32x4 r;
#pragma unroll
    for (int e = 0; e < 4; ++e) r[e] = __int_as_float(__builtin_amdgcn_update_dpp(0, __float_as_int(v[e]), CTRL, 0xf, 0xf, true));
    return r; }
struct EpiUp {
    static constexpr bool PERM = true, AFTER_DRAIN = false;
    static __device__ __forceinline__ bool zero_after(const Unit&) { return true; }
    const float* ssq; bf16_t* u; float* halo; const float* cw; const float* cb;
    __device__ __forceinline__ void operator()(ACC_T, const Unit& un, int wr, int wc, int fr, int fq) const {
        const int row0 = un.pm * 256 + wr * 64 + fr; const int col = un.pn * 128 + 32 * wc + 8 * fq;
#pragma unroll
        for (int ai = 0; ai < 2; ++ai)
#pragma unroll
            for (int m = 0; m < 4; ++m) { const int row = row0 + ai * 128 + m * 16;
                const f32x4 s0 = *(const f32x4*)(ssq + (size_t)row * 16 + 4 * fq);
                float tot = (s0[0] + s0[1]) + (s0[2] + s0[3]); tot += __shfl_xor(tot, 16); tot += __shfl_xor(tot, 32);
                const float rs = rsqrtf(tot * (1.0f / 1024.0f) + EPS);
#pragma unroll
                for (int bj = 0; bj < 2; ++bj) { acc[ai][bj][m][0] = acc[ai][bj][m][0] * rs; acc[ai][bj][m][1] = acc[ai][bj][m][1] * rs; } }
        asm volatile("" ::: "memory");
#pragma unroll
        for (int ai = 0; ai < 2; ++ai) {
            const int grp = un.pm * 4 + ai * 2 + wr;
            float* hb = halo + (size_t)grp * 6 * DFF + col;
            if (fr >= 14) { *(f32x4*)(hb + (size_t)(fr - 14) * DFF) = acc[ai][0][3][0]; *(f32x4*)(hb + (size_t)(fr - 14) * DFF + 4) = acc[ai][0][3][1]; }
            if (fr < 2) { *(f32x4*)(hb + (size_t)(2 + fr) * DFF) = acc[ai][0][0][0]; *(f32x4*)(hb + (size_t)(2 + fr) * DFF + 4) = acc[ai][0][0][1];
                          *(f32x4*)(hb + (size_t)(4 + fr) * DFF) = acc[ai][1][0][0]; *(f32x4*)(hb + (size_t)(4 + fr) * DFF + 4) = acc[ai][1][0][1]; }
            __builtin_amdgcn_sched_barrier(0);
#pragma unroll
            for (int n = 0; n < 2; ++n) {
                const f32x4 w0 = *(const f32x4*)(cw + col + 4 * n), w1 = *(const f32x4*)(cw + DFF + col + 4 * n), w2 = *(const f32x4*)(cw + 2 * DFF + col + 4 * n), bi = *(const f32x4*)(cb + col + 4 * n);
#pragma unroll
                for (int m = 0; m < 4; ++m) { const f32x4 a = acc[ai][0][m][n]; const f32x4 ap = m > 0 ? acc[ai][0][m - 1][n] : a;
                    const f32x4 c1 = fr == 15 ? ap : a, c2 = fr >= 14 ? ap : a;
                    const f32x4 p1 = dpp4<0x121>(c1), p2 = dpp4<0x122>(c2);
                    f32x4 z = w0 * p2 + w1 * p1 + w2 * a + bi;
#pragma unroll
                    for (int e = 0; e < 4; ++e) z[e] = z[e] * fast_sigmoid(z[e]);
                    acc[ai][1][m][n] = z * acc[ai][1][m][n];
                    }
            }
#pragma unroll
            for (int m = 0; m < 4; ++m) { const int row = row0 + ai * 128 + m * 16;
                *(u32x4*)(u + (size_t)row * DFF + col)     = pack8(acc[ai][1][m][0], acc[ai][1][m][1]); }
        }
    }
};

struct EpiDown {
    static constexpr bool PERM = true, AFTER_DRAIN = false;
    static __device__ __forceinline__ bool zero_after(const Unit&) { return true; }
    float* out;
    __device__ __forceinline__ void operator()(ACC_T, const Unit& u, int wr, int wc, int fr, int fq) const {
        const int row0 = u.pm * 256 + wr * 64 + fr;
#pragma unroll
        for (int ai = 0; ai < 2; ++ai)
#pragma unroll
            for (int m = 0; m < 4; ++m) { const int row = row0 + ai * 128 + m * 16;
#pragma unroll
                for (int bj = 0; bj < 2; ++bj) { const size_t o = (size_t)row * 1024 + u.pn * 256 + 128 * bj + 32 * wc + 8 * fq;
                    *(f32x4*)(out + o) = *(const f32x4*)(out + o) + acc[ai][bj][m][0]; *(f32x4*)(out + o + 4) = *(const f32x4*)(out + o + 4) + acc[ai][bj][m][1]; } }
    }
};

__device__ __forceinline__ float wave_sum(float v) {
#pragma unroll
    for (int o = 1; o < 64; o <<= 1) v += __shfl_xor(v, o);
    return v;
}
__device__ __forceinline__ float wave_max(float v) {
#pragma unroll
    for (int o = 1; o < 64; o <<= 1) v = fmaxf(v, __shfl_xor(v, o));
    return v;
}
__device__ __forceinline__ void transpose_item(const float* __restrict__ W, int N, int K, const float* __restrict__ g, bf16_t* WT, int k0, int s0, int dA, int dB, LAS float* scr, int lane) {
    const int lr = lane >> 4, lc = (lane & 15) * 4;
    f32x4 v[16];
#pragma unroll
    for (int i = 0; i < 16; ++i) v[i] = *(const f32x4*)(W + (size_t)(k0 + 4 * i + lr) * N + s0 + lc);
#pragma unroll
    for (int i = 0; i < 16; ++i) { const int kk = 4 * i + lr; f32x4 t = v[i]; if (g) t = t * g[k0 + kk];
        LAS float* d = scr + kk * 65 + lc; d[0] = t[0]; d[1] = t[1]; d[2] = t[2]; d[3] = t[3]; }
    asm volatile("s_waitcnt lgkmcnt(0)" ::: "memory");
    const int c = lane & 7;
#pragma unroll
    for (int j = 0; j < 8; ++j) { const int n = (lane >> 3) + 8 * j; const LAS float* s = scr + (8 * c) * 65 + n;
        u32x4 o; o.x = cvt_pk_bf16(s[0 * 65], s[1 * 65]); o.y = cvt_pk_bf16(s[2 * 65], s[3 * 65]); o.z = cvt_pk_bf16(s[4 * 65], s[5 * 65]); o.w = cvt_pk_bf16(s[6 * 65], s[7 * 65]);
        const int drow = n < 32 ? dA + n : dB + (n - 32);
        *(u32x4*)(WT + (size_t)drow * K + k0 + 8 * c) = o; }
    asm volatile("s_waitcnt lgkmcnt(0)" ::: "memory");
}
template <int NR> __device__ __forceinline__ void rows_to_bf16(const float* x, bf16_t* o, int m0, int stride, int lane) {
    f32x4 v[NR][4];
#pragma unroll
    for (int r = 0; r < NR; ++r) { const f32x4* xr = (const f32x4*)(x + (size_t)(m0 + r * stride) * 1024) + lane;
#pragma unroll
        for (int j = 0; j < 4; ++j) v[r][j] = xr[64 * j]; }
#pragma unroll
    for (int r = 0; r < NR; ++r) { float s = 0.f;
#pragma unroll
        for (int j = 0; j < 4; ++j) s += (v[r][j].x * v[r][j].x + v[r][j].y * v[r][j].y) + (v[r][j].z * v[r][j].z + v[r][j].w * v[r][j].w);
        s = wave_sum(s);
        const float rs = rsqrtf(s * (1.0f / 1024.0f) + EPS);
        u32x2* o8 = (u32x2*)(o + (size_t)(m0 + r * stride) * 1024) + lane;
#pragma unroll
        for (int j = 0; j < 4; ++j) { const f32x4 t = v[r][j] * rs; o8[64 * j] = (u32x2){cvt_pk_bf16(t.x, t.y), cvt_pk_bf16(t.z, t.w)}; } }
}
__device__ __forceinline__ void phase_prep(const Params& P, LAS unsigned char* lds) {
    const int tid = threadIdx.x, lane = tid & 63, wave = tid >> 6;
    const int gw = blockIdx.x * 8 + wave, NGW = gridDim.x * 8;
    unsigned char* ws = P.ws;
    { float* kb = (float*)(ws + WS_KBAR); for (int i = blockIdx.x * 512 + tid; i < 16 * 8 * 16 * 64; i += gridDim.x * 512) kb[i] = 0.f; }
    LAS float* scr = (LAS float*)(lds + wave * 17408);
    constexpr int I_IN = 16 * (INC / 64), I_KV = 16 * 16, I_BR = 8 * 16, I_O = 16 * 16, I_UP = 16 * (2 * DFF / 64), I_DN = (DFF / 64) * 16;
    constexpr int NIT = I_IN + I_KV + 3 * I_BR + I_O + I_UP + I_DN;
    for (int it = gw; it < NIT; it += NGW) {
        int r = it;
        if (r < I_IN) { const int nb = r % (INC / 64), kb = r / (INC / 64), s0 = nb * 64, pn = s0 >> 8, wcs = (s0 & 255) >> 6;
            transpose_item(P.w_in, INC, 1024, P.g_mix, (bf16_t*)(ws + WS_W1T), kb * 64, s0, pn * 256 + 32 * wcs, pn * 256 + 128 + 32 * wcs, scr, lane); continue; } r -= I_IN;
        if (r < I_KV) { const int d = (r % 16) * 64; transpose_item(P.w_mem_kv, 1024, 1024, P.g_mem, (bf16_t*)(ws + WS_WKVT), (r / 16) * 64, d, d, d + 32, scr, lane); continue; } r -= I_KV;
        if (r < 3 * I_BR) { const int wsel = r / I_BR, q = r % I_BR, d = (q % 16) * 64; const float* W = wsel == 0 ? P.w_br_conv : (wsel == 1 ? P.w_br_moba : P.w_br_mem);
            transpose_item(W, 1024, 512, nullptr, (bf16_t*)(ws + WS_WBRT) + (size_t)wsel * 1024 * 512, (q / 16) * 64, d, d, d + 32, scr, lane); continue; } r -= 3 * I_BR;
        if (r < I_O) { const int d = (r % 16) * 64; transpose_item(P.w_o, 1024, 1024, nullptr, (bf16_t*)(ws + WS_WOT), (r / 16) * 64, d, d, d + 32, scr, lane); continue; } r -= I_O;
        if (r < I_UP) { const int nb = r % (2 * DFF / 64), kb = r / (2 * DFF / 64), d0 = nb * 64, p0 = d0 & 255, pn = d0 >> 8; const int sc = p0 < 128 ? pn * 128 + p0 : DFF + pn * 128 + (p0 - 128);
            transpose_item(P.w_up, 2 * DFF, 1024, P.g_ffn, (bf16_t*)(ws + WS_WUPT), kb * 64, sc, d0, d0 + 32, scr, lane); continue; } r -= I_UP;
        { const int d = (r % 16) * 64; transpose_item(P.w_down, 1024, DFF, nullptr, (bf16_t*)(ws + WS_WDNT), (r / 16) * 64, d, d, d + 32, scr, lane); }
    }
    bf16_t* xb = (bf16_t*)P.out;
    if ((T_TOK % (4 * NGW)) == 0) { for (int m = gw; m < T_TOK; m += 4 * NGW) rows_to_bf16<4>(P.x, xb, m, NGW, lane); }
    else { for (int m = gw; m < T_TOK; m += NGW) rows_to_bf16<1>(P.x, xb, m, NGW, lane); }
    for (int m = gw; m < MEMT; m += NGW) rows_to_bf16<1>(P.mem, (bf16_t*)(ws + WS_MEMB), m, NGW, lane);
}

__device__ __forceinline__ int crow(int r, int hi) { return (r & 3) + 8 * (r >> 2) + 4 * hi; }
#define MFMA32(a, b, c) __builtin_amdgcn_mfma_f32_32x32x16_bf16((a), (b), (c), 0, 0, 0)

constexpr int MOBA_KS = 144, MOBA_VS = 520, MOBA_VOFF = 256 * MOBA_KS;
__device__ __forceinline__ unsigned moba_select(const float* kbar, int b, int h, int n, int ql, int hi, const bf16x8 (&qf)[4]) {
    f32x16 g;
#pragma unroll
    for (int i = 0; i < 16; ++i) g[i] = 0.f;
    const float* kb = kbar + ((size_t)(b * 8 + h) * 16 + (ql & 15)) * 64 + 8 * hi;
#pragma unroll
    for (int ks = 0; ks < 4; ++ks) { f32x4 x0 = *(const f32x4*)(kb + 16 * ks), x1 = *(const f32x4*)(kb + 16 * ks + 4);
        if (ql >= 16) { x0 = (f32x4){0.f, 0.f, 0.f, 0.f}; x1 = x0; }
        const u32x4 pk = pack8(x0 * (1.0f / 256.0f), x1 * (1.0f / 256.0f)); g = MFMA32(__builtin_bit_cast(bf16x8, pk), qf[ks], g); }
    float gv[16];
#pragma unroll
    for (int i = 0; i < 8; ++i) { const float own = g[i], oth = __shfl_xor(own, 32); const int bb = (i & 3) + 8 * (i >> 2); gv[bb] = hi ? oth : own; gv[bb + 4] = hi ? own : oth; }
#pragma unroll
    for (int j = 0; j < 16; ++j) if (j >= n) gv[j] = -INFINITY;
    unsigned selmask = 0;
#pragma unroll
    for (int t = 0; t < 3; ++t) { float best = -INFINITY; int bi = -1;
#pragma unroll
        for (int j = 0; j < 16; ++j) if (gv[j] > best) { best = gv[j]; bi = j; }
        if (bi >= 0) selmask |= 1u << bi;
#pragma unroll
        for (int j = 0; j < 16; ++j) if (j == bi) gv[j] = -INFINITY; }
    return selmask;
}
__device__ __forceinline__ void moba_unit(const Params& P, LAS unsigned char* lds, int b, int h, int n, bool first, int nnext, u32x4 (&kr)[4], u32x4 (&vr)[4]) {
    int tid = threadIdx.x; asm volatile("" : "+v"(tid));
    const int lane = tid & 63, w = __builtin_amdgcn_readfirstlane(tid >> 6), ql = lane & 31, hi = lane >> 5, qg = w & 3, kh = w >> 2;
    const bf16_t* qk = (const bf16_t*)(P.ws + WS_QK); const bf16_t* vT = (const bf16_t*)(P.ws + WS_VT); const float* kbar = (const float*)(P.ws + WS_KBAR);
    bf16_t* ymoba = (bf16_t*)P.out + (size_t)T_TOK * 512;
    LAS unsigned char* Ks = lds; LAS unsigned char* Vt = lds + MOBA_VOFF;
    const size_t tq0 = (size_t)b * SEQ + 256 * n + 64 * qg + ql;
    bf16x8 qf[2][4];
#pragma unroll
    for (int c = 0; c < 2; ++c)
#pragma unroll
        for (int ks = 0; ks < 4; ++ks) qf[c][ks] = *(const bf16x8*)(qk + (tq0 + 32 * c) * 1024 + h * 64 + 16 * ks + 8 * hi);
    unsigned selm0 = 0, selm1 = 0;
    if (n > 0) { selm0 = moba_select(kbar, b, h, n, ql, hi, qf[0]); selm1 = moba_select(kbar, b, h, n, ql, hi, qf[1]); }
    f32x16 o[2][2];
#pragma unroll
    for (int c = 0; c < 2; ++c)
#pragma unroll
        for (int d = 0; d < 2; ++d)
#pragma unroll
            for (int i = 0; i < 16; ++i) o[c][d][i] = 0.f;
    float ls[2] = {0.f, 0.f};
    const bf16_t* kbase = qk + ((size_t)b * SEQ) * 1024 + 512 + h * 64; const bf16_t* vbase = vT + ((size_t)(b * 8 + h) * 64) * 4096;
#define MOBA_LOAD(j) do { int t2 = tid; asm volatile("" : "+v"(t2)); _Pragma("unroll") for (int i = 0; i < 4; ++i) { const int p = t2 + 512 * i; \
        kr[i] = *(const u32x4*)(kbase + (size_t)(256 * (j) + (p >> 3)) * 1024 + (p & 7) * 8); \
        vr[i] = *(const u32x4*)(vbase + (size_t)(p >> 5) * 4096 + 256 * (j) + (p & 31) * 8); } } while (0)
    if (first) MOBA_LOAD(n);
    f32x16 zero16;
#pragma unroll
    for (int i = 0; i < 16; ++i) zero16[i] = 0.f;
    for (int it = 0; it <= n; ++it) {
        const int j = (it == 0) ? n : it - 1;
        __syncthreads();
        int t3 = tid; asm volatile("" : "+v"(t3));
#pragma unroll
        for (int i = 0; i < 4; ++i) { const int p = t3 + 512 * i;
            *(LAS u32x4*)(Ks + (p >> 3) * MOBA_KS + (p & 7) * 16) = kr[i];
            LAS unsigned char* vp = Vt + (p >> 5) * MOBA_VS + (p & 31) * 16;
            *(LAS u32x2*)vp = (u32x2){vr[i].x, vr[i].y}; *(LAS u32x2*)(vp + 8) = (u32x2){vr[i].z, vr[i].w}; }
        __syncthreads();
        if (it < n) MOBA_LOAD(it); else if (nnext >= 0) MOBA_LOAD(nnext);
        const bool own = (j == n);
        const bool sel0 = own || ((selm0 >> j) & 1u), sel1 = own || ((selm1 >> j) & 1u);
        if (__ballot(sel0 || sel1) == 0ull) continue;
        const unsigned selw0 = sel0 ? 0xffffffffu : 0u, selw1 = sel1 ? 0xffffffffu : 0u;
        float lb0 = 0.f, lb1 = 0.f;
        const int ntl = own ? (2 * qg + 2 - 4 * kh) : 4;
        for (int t = 0; t < ntl && t < 4; ++t) {
            const int kt = 4 * kh + t;
            const LAS unsigned char* kp = Ks + (32 * kt + ql) * MOBA_KS + 16 * hi;
            bf16x8 kf[4];
#pragma unroll
            for (int ks = 0; ks < 4; ++ks) kf[ks] = *(const LAS bf16x8*)(kp + 32 * ks);
            __builtin_amdgcn_sched_barrier(0);
            f32x16 s0 = MFMA32(kf[0], qf[0][0], zero16);
#pragma unroll
            for (int ks = 1; ks < 4; ++ks) s0 = MFMA32(kf[ks], qf[0][ks], s0);
            f32x16 s1 = MFMA32(kf[0], qf[1][0], zero16);
#pragma unroll
            for (int ks = 1; ks < 4; ++ks) s1 = MFMA32(kf[ks], qf[1][ks], s1);
            __builtin_amdgcn_sched_barrier(0);
            const LAS unsigned char* vp = Vt + ql * MOBA_VS + (32 * kt + 4 * hi) * 2;
            u32x2 vf[2][2][2];
#pragma unroll
            for (int d = 0; d < 2; ++d)
#pragma unroll
                for (int k2 = 0; k2 < 2; ++k2) { vf[d][k2][0] = *(const LAS u32x2*)(vp + 32 * d * MOBA_VS + 32 * k2); vf[d][k2][1] = *(const LAS u32x2*)(vp + 32 * d * MOBA_VS + 32 * k2 + 16); }
            __builtin_amdgcn_sched_barrier(0);
            if (own) {
                if (kt == 2 * qg) {
#pragma unroll
                    for (int i = 0; i < 16; ++i) if (crow(i, hi) > ql) s0[i] = -1e30f;
                }
                if (kt == 2 * qg + 1) {
#pragma unroll
                    for (int i = 0; i < 16; ++i) { s0[i] = -1e30f; if (crow(i, hi) > ql) s1[i] = -1e30f; }
                }
            }
            u32x4 pa[2];
#pragma unroll
            for (int i = 0; i < 8; ++i) { const float e0 = __builtin_amdgcn_exp2f(s0[2 * i]), e1 = __builtin_amdgcn_exp2f(s0[2 * i + 1]); lb0 += e0; lb0 += e1; pa[i >> 2][i & 3] = cvt_pk_bf16_t(e0, e1) & selw0; }
            __builtin_amdgcn_sched_barrier(0);
            bf16x8 av[2][2];
#pragma unroll
            for (int k2 = 0; k2 < 2; ++k2)
#pragma unroll
                for (int d = 0; d < 2; ++d) { const u32x4 a = (u32x4){vf[d][k2][0].x, vf[d][k2][0].y, vf[d][k2][1].x, vf[d][k2][1].y}; av[d][k2] = __builtin_bit_cast(bf16x8, a); }
#pragma unroll
            for (int k2 = 0; k2 < 2; ++k2)
#pragma unroll
                for (int d = 0; d < 2; ++d) o[0][d] = MFMA32(av[d][k2], __builtin_bit_cast(bf16x8, pa[k2]), o[0][d]);
            __builtin_amdgcn_sched_barrier(0);
            u32x4 pb[2];
#pragma unroll
            for (int i = 0; i < 8; ++i) { const float e0 = __builtin_amdgcn_exp2f(s1[2 * i]), e1 = __builtin_amdgcn_exp2f(s1[2 * i + 1]); lb1 += e0; lb1 += e1; pb[i >> 2][i & 3] = cvt_pk_bf16_t(e0, e1) & selw1; }
            __builtin_amdgcn_sched_barrier(0);
#pragma unroll
            for (int k2 = 0; k2 < 2; ++k2)
#pragma unroll
                for (int d = 0; d < 2; ++d) o[1][d] = MFMA32(av[d][k2], __builtin_bit_cast(bf16x8, pb[k2]), o[1][d]);
            __builtin_amdgcn_sched_barrier(0);
        }
        if (sel0) ls[0] += lb0;
        if (sel1) ls[1] += lb1;
    }
#undef MOBA_LOAD
    ls[0] += __shfl_xor(ls[0], 32); ls[1] += __shfl_xor(ls[1], 32);
    __syncthreads();
    LAS float* xo = (LAS float*)lds; LAS float* xl = (LAS float*)(lds + 65536);
    if (kh == 1) {
#pragma unroll
        for (int c = 0; c < 2; ++c) { xl[(qg * 2 + c) * 64 + lane] = ls[c];
#pragma unroll
            for (int d = 0; d < 2; ++d)
#pragma unroll
                for (int i = 0; i < 16; ++i) xo[(((qg * 2 + c) * 2 + d) * 16 + i) * 64 + lane] = o[c][d][i]; }
    }
    __syncthreads();
    if (kh == 0) {
#pragma unroll
        for (int c = 0; c < 2; ++c) { const float inv = 1.0f / (ls[c] + xl[(qg * 2 + c) * 64 + lane]);
            bf16_t* yp = ymoba + (tq0 + 32 * c) * 512 + h * 64 + 4 * hi;
#pragma unroll
            for (int d = 0; d < 2; ++d) {
                float v[16];
#pragma unroll
                for (int i = 0; i < 16; ++i) v[i] = (o[c][d][i] + xo[(((qg * 2 + c) * 2 + d) * 16 + i) * 64 + lane]) * inv;
#pragma unroll
                for (int g4 = 0; g4 < 4; ++g4) *(u32x2*)(yp + 32 * d + 8 * g4) = (u32x2){cvt_pk_bf16(v[4 * g4], v[4 * g4 + 1]), cvt_pk_bf16(v[4 * g4 + 2], v[4 * g4 + 3])}; }
        }
    }
}

constexpr int MEM_KS = 272, MEM_VS = 520, MEM_VOFF = 256 * MEM_KS;
__device__ __forceinline__ void mem_unit(const Params& P, LAS unsigned char* lds, int b, int hm, int qt0) {
    const int tid = threadIdx.x, lane = tid & 63, w = tid >> 6, ql = lane & 31, hi = lane >> 5;
    const bf16_t* qm = (const bf16_t*)(P.ws + WS_QM); const bf16_t* memk = (const bf16_t*)(P.ws + WS_MEMK); const bf16_t* memvT = (const bf16_t*)(P.ws + WS_MEMVT);
    bf16_t* ymem = (bf16_t*)P.out + (size_t)T_TOK * 1024;
    LAS unsigned char* Km = lds; LAS unsigned char* Vm = lds + MEM_VOFF;
    __syncthreads();
#pragma unroll
    for (int i = 0; i < 8; ++i) { const int p = tid + 512 * i, row = p >> 4, c = p & 15;
        f32x4 f0, f1; unpack8(*(const u32x4*)(memk + ((size_t)b * 256 + row) * 512 + hm * 128 + c * 8), f0, f1);
        const f32x4 q0 = f0 * f0, q1 = f1 * f1; float ss = ((q0[0] + q0[1]) + (q0[2] + q0[3])) + ((q1[0] + q1[1]) + (q1[2] + q1[3]));
        ss += __shfl_xor(ss, 1); ss += __shfl_xor(ss, 2); ss += __shfl_xor(ss, 4); ss += __shfl_xor(ss, 8);
        const float rk = rsqrtf(ss * (1.0f / 128.0f) + EPS);
        const f32x4 g0 = *(const f32x4*)(P.memk_g + c * 8), g1 = *(const f32x4*)(P.memk_g + c * 8 + 4);
        *(LAS u32x4*)(Km + row * MEM_KS + c * 16) = pack8(f0 * rk * g0, f1 * rk * g1); }
#pragma unroll
    for (int i = 0; i < 8; ++i) { const int p = tid + 512 * i, d = p >> 5, c = p & 31;
        const u32x4 v = *(const u32x4*)(memvT + ((size_t)(b * 4 + hm) * 128 + d) * 256 + c * 8);
        LAS unsigned char* vp = Vm + d * MEM_VS + c * 16; *(LAS u32x2*)vp = (u32x2){v.x, v.y}; *(LAS u32x2*)(vp + 8) = (u32x2){v.z, v.w}; }
    __syncthreads();
    for (int qt = qt0; qt < qt0 + 4; ++qt) {
        const size_t tq = (size_t)b * SEQ + 256 * qt + 32 * w + ql;
        bf16x8 qf[8];
        { f32x4 f[8][2]; float ss = 0.f;
#pragma unroll
            for (int ks = 0; ks < 8; ++ks) { unpack8(*(const u32x4*)(qm + tq * 512 + hm * 128 + 16 * ks + 8 * hi), f[ks][0], f[ks][1]);
                const f32x4 q0 = f[ks][0] * f[ks][0], q1 = f[ks][1] * f[ks][1]; ss += ((q0[0] + q0[1]) + (q0[2] + q0[3])) + ((q1[0] + q1[1]) + (q1[2] + q1[3])); }
            ss += __shfl_xor(ss, 32);
            const float rq = rsqrtf(ss * (1.0f / 128.0f) + EPS) * C2_MEM;
#pragma unroll
            for (int ks = 0; ks < 8; ++ks) { const f32x4 g0 = *(const f32x4*)(P.memq_g + 16 * ks + 8 * hi), g1 = *(const f32x4*)(P.memq_g + 16 * ks + 8 * hi + 4);
                const u32x4 pk = pack8(f[ks][0] * rq * g0, f[ks][1] * rq * g1); qf[ks] = __builtin_bit_cast(bf16x8, pk); } }
        f32x16 o[4];
#pragma unroll
        for (int d = 0; d < 4; ++d)
#pragma unroll
            for (int i = 0; i < 16; ++i) o[d][i] = 0.f;
        float lsum = 0.f;
        for (int kt = 0; kt < 8; ++kt) {
            f32x16 s;
#pragma unroll
            for (int i = 0; i < 16; ++i) s[i] = 0.f;
            const LAS unsigned char* kp = Km + (32 * kt + ql) * MEM_KS + 16 * hi;
#pragma unroll
            for (int ks = 0; ks < 8; ++ks) s = MFMA32(*(const LAS bf16x8*)(kp + 32 * ks), qf[ks], s);
            float pe[16];
#pragma unroll
            for (int i = 0; i < 16; ++i) { pe[i] = __builtin_amdgcn_exp2f(s[i]); lsum += pe[i]; }
            u32x4 pa0, pa1;
            pa0.x = cvt_pk_bf16_t(pe[0], pe[1]); pa0.y = cvt_pk_bf16_t(pe[2], pe[3]); pa0.z = cvt_pk_bf16_t(pe[4], pe[5]); pa0.w = cvt_pk_bf16_t(pe[6], pe[7]);
            pa1.x = cvt_pk_bf16_t(pe[8], pe[9]); pa1.y = cvt_pk_bf16_t(pe[10], pe[11]); pa1.z = cvt_pk_bf16_t(pe[12], pe[13]); pa1.w = cvt_pk_bf16_t(pe[14], pe[15]);
            const LAS unsigned char* vp = Vm + ql * MEM_VS + (32 * kt + 4 * hi) * 2;
#pragma unroll
            for (int kf = 0; kf < 2; ++kf) { const bf16x8 pb = __builtin_bit_cast(bf16x8, kf ? pa1 : pa0);
#pragma unroll
                for (int d = 0; d < 4; ++d) { const u32x2 lo = *(const LAS u32x2*)(vp + 32 * d * MEM_VS + 32 * kf), h8 = *(const LAS u32x2*)(vp + 32 * d * MEM_VS + 32 * kf + 16);
                    const u32x4 a = (u32x4){lo.x, lo.y, h8.x, h8.y}; o[d] = MFMA32(__builtin_bit_cast(bf16x8, a), pb, o[d]); } }
        }
        lsum += __shfl_xor(lsum, 32);
        const float inv = 1.0f / lsum;
        bf16_t* yp = ymem + tq * 512 + hm * 128 + 4 * hi;
#pragma unroll
        for (int d = 0; d < 4; ++d)
#pragma unroll
            for (int g4 = 0; g4 < 4; ++g4)
                *(u32x2*)(yp + 32 * d + 8 * g4) = (u32x2){cvt_pk_bf16(o[d][4 * g4] * inv, o[d][4 * g4 + 1] * inv), cvt_pk_bf16(o[d][4 * g4 + 2] * inv, o[d][4 * g4 + 3] * inv)};
    }
}

__device__ __forceinline__ void conv_slice(const Params& P, int slice) {
    const bf16_t* cv = (const bf16_t*)(P.ws + WS_CONV); bf16_t* yc = (bf16_t*)P.out;
    const int tid = threadIdx.x;
    for (int i = 0; i < 4; ++i) { const int item = tid + 512 * i, cgp = item & 63, rg = item >> 6; const int t0 = slice * 256 + 8 * rg, c = 8 * cgp;
        f32x4 w0[2], w1[2], w2[2], bi[2];
#pragma unroll
        for (int k = 0; k < 2; ++k) { w0[k] = *(const f32x4*)(P.conv_w + c + 4 * k); w1[k] = *(const f32x4*)(P.conv_w + 512 + c + 4 * k); w2[k] = *(const f32x4*)(P.conv_w + 1024 + c + 4 * k); bi[k] = *(const f32x4*)(P.conv_b + c + 4 * k); }
        const bool first = (t0 & (SEQ - 1)) == 0;
        u32x4 rc[10], rx[10], rb[8];
#pragma unroll
        for (int r = 0; r < 10; ++r) { const size_t t = (size_t)(t0 - 2 + r);
            if (r >= 2 || !first) { rc[r] = *(const u32x4*)(cv + t * 1536 + 512 + c); rx[r] = *(const u32x4*)(cv + t * 1536 + 1024 + c); } else { rc[r] = (u32x4){0u, 0u, 0u, 0u}; rx[r] = rc[r]; }
            if (r >= 2) rb[r - 2] = *(const u32x4*)(cv + t * 1536 + c); }
        f32x4 m2[2], m1[2];
        { f32x4 a0, a1, b0, b1; unpack8(rc[0], a0, a1); unpack8(rx[0], b0, b1); m2[0] = a0 * b0; m2[1] = a1 * b1; unpack8(rc[1], a0, a1); unpack8(rx[1], b0, b1); m1[0] = a0 * b0; m1[1] = a1 * b1; }
#pragma unroll
        for (int r = 0; r < 8; ++r) { const size_t t = (size_t)(t0 + r); f32x4 a0, a1, b0, b1, g0, g1;
            unpack8(rc[r + 2], a0, a1); unpack8(rx[r + 2], b0, b1); unpack8(rb[r], g0, g1);
            const f32x4 m00 = a0 * b0, m01 = a1 * b1;
            const f32x4 y0 = g0 * (w0[0] * m2[0] + w1[0] * m1[0] + w2[0] * m00 + bi[0]), y1 = g1 * (w0[1] * m2[1] + w1[1] * m1[1] + w2[1] * m01 + bi[1]);
            *(u32x4*)(yc + t * 512 + c) = pack8(y0, y1);
            m2[0] = m1[0]; m2[1] = m1[1]; m1[0] = m00; m1[1] = m01; }
    }
}

__device__ __forceinline__ void phase_mixers(const Params& P, LAS unsigned char* lds) {
    if (P.sub & 1) for (int c = blockIdx.x; c < 256; c += gridDim.x) {
        const int bh = c >> 1, odd = c & 1;
        u32x4 kr[4], vr[4];
        for (int i = 0; i < 8; ++i) { const int e = 2 * (i >> 1); const int n = (i & 1) ? (15 - e - odd) : (e + odd);
            const int i2 = i + 1, e2 = 2 * (i2 >> 1); const int nn = i2 < 8 ? ((i2 & 1) ? (15 - e2 - odd) : (e2 + odd)) : -1;
            moba_unit(P, lds, bh >> 3, bh & 7, n, i == 0, nn, kr, vr); }
    }
    if (P.sub & 2) for (int c = blockIdx.x; c < 256; c += gridDim.x) mem_unit(P, lds, c >> 4, (c >> 2) & 3, (c & 3) * 4);
    if (P.sub & 4) for (int c = blockIdx.x; c < 256; c += gridDim.x) conv_slice(P, c);
}

__device__ __forceinline__ void phase_ffn_fix(const Params& P) {
    const float* halo = (const float*)(P.ws + WS_AR); bf16_t* u = (bf16_t*)(P.ws + WS_BU);
    constexpr int CG = DFF / 8;
    const int total = 1024 * 2 * CG;
    for (int idx = blockIdx.x * 512 + threadIdx.x; idx < total; idx += gridDim.x * 512) {
        const int cgp = idx % CG, rr = idx / CG, r = rr & 1, G = rr >> 1, c = cgp * 8;
        const bool seq0 = (G & 63) == 0;
        const float* hg = halo + (size_t)G * 6 * DFF + c; const float* hp = halo + (size_t)(G - 1) * 6 * DFF + c;
        f32x4 z[2];
#pragma unroll
        for (int k = 0; k < 2; ++k) {
            const f32x4 w0 = *(const f32x4*)(P.ffn_conv_w + c + 4 * k), w1 = *(const f32x4*)(P.ffn_conv_w + DFF + c + 4 * k), w2 = *(const f32x4*)(P.ffn_conv_w + 2 * DFF + c + 4 * k), bi = *(const f32x4*)(P.ffn_conv_b + c + 4 * k);
            const f32x4 zero = (f32x4){0.f, 0.f, 0.f, 0.f};
            const f32x4 a = *(const f32x4*)(hg + (size_t)(2 + r) * DFF + 4 * k), b = *(const f32x4*)(hg + (size_t)(4 + r) * DFF + 4 * k);
            f32x4 p1, p2;
            if (r == 0) { p1 = seq0 ? zero : *(const f32x4*)(hp + (size_t)1 * DFF + 4 * k); p2 = seq0 ? zero : *(const f32x4*)(hp + 4 * k); }
            else { p1 = *(const f32x4*)(hg + (size_t)2 * DFF + 4 * k); p2 = seq0 ? zero : *(const f32x4*)(hp + (size_t)1 * DFF + 4 * k); }
            f32x4 t = w0 * p2 + w1 * p1 + w2 * a + bi;
#pragma unroll
            for (int e = 0; e < 4; ++e) t[e] = t[e] * fast_sigmoid(t[e]) * b[e];
            z[k] = t; }
        *(u32x4*)(u + (size_t)(G * 64 + r) * DFF + c) = pack8(z[0], z[1]);
    }
}

#define XB_TMO      128
#define XB_XCNT(j)  (256  + 64 * (j))
#define XB_XSUB(j)  (1280 + 64 * (j))
#define XB_XGEN(j)  (2304 + 64 * (j))
#define XB_TOP      3328
#define XB_TOPGEN   3392
#define XCD_BAR_WORDS 3456
#define XB_SPIN_CAP (1u << 18)

__device__ __forceinline__ unsigned xb_ld(unsigned* p)              { return __hip_atomic_load(p, __ATOMIC_RELAXED, __HIP_MEMORY_SCOPE_AGENT); }
__device__ __forceinline__ unsigned xb_add(unsigned* p, unsigned v) { return __hip_atomic_fetch_add(p, v, __ATOMIC_RELAXED, __HIP_MEMORY_SCOPE_AGENT); }
__device__ __forceinline__ unsigned xb_xcc_id() { return (unsigned)__builtin_amdgcn_s_getreg((3 << 11) | 20) & 0xFu; }
#define XB_SPIN(cond, bar) do { unsigned _sp = 0; while (cond) { __builtin_amdgcn_s_sleep(1); \
    if ((++_sp & 255u) == 0u) { if (xb_ld(&(bar)[XB_TMO])) break; if (_sp > XB_SPIN_CAP) { atomicAdd(&(bar)[XB_TMO], 1u); break; } } } } while (0)

struct XcdBarrier {
    unsigned* bar; unsigned x;
    volatile LAS unsigned* st;
};

__device__ __forceinline__ XcdBarrier xcd_barrier_post(unsigned* bar, volatile LAS unsigned* st) {
    XcdBarrier b; b.bar = bar; b.x = xb_xcc_id(); b.st = st;
    if (threadIdx.x == 0) (void)xb_add(&bar[XB_XCNT(b.x)], 1u);
    return b;
}
__device__ __forceinline__ void xcd_barrier_complete(unsigned* bar, unsigned x, unsigned& nloc, unsigned& nx) {
    const unsigned G = gridDim.x;
    unsigned sum, cnt, mine, sp = 0u;
    for (;;) {
        sum = 0u; cnt = 0u; mine = 0u;
#pragma unroll
        for (unsigned j = 0; j < 16; ++j) { const unsigned c = xb_ld(&bar[XB_XCNT(j)]); sum += c; cnt += (c > 0u) ? 1u : 0u; mine = (j == x) ? c : mine; }
        if (sum == G) break;
        __builtin_amdgcn_s_sleep(1);
        if ((++sp & 255u) == 0u) { if (xb_ld(&bar[XB_TMO])) break; if (sp > XB_SPIN_CAP) { atomicAdd(&bar[XB_TMO], 1u); break; } }
    }
    nloc = mine > 0u ? mine : 1u; nx = cnt > 0u ? cnt : 1u;
}

__device__ __forceinline__ void xcd_barrier(const XcdBarrier& b) {
    asm volatile("s_waitcnt vmcnt(0)" ::: "memory");
    __syncthreads();
    if (threadIdx.x == 0) {
        unsigned* bar = b.bar;
        __builtin_amdgcn_s_waitcnt(0);
        unsigned nloc = b.st[0], nx = b.st[1];
        if (nloc == 0u) { xcd_barrier_complete(bar, b.x, nloc, nx); b.st[0] = nloc; b.st[1] = nx; }
        const unsigned old = xb_add(&bar[XB_XSUB(b.x)], 1u);
        const unsigned gen = old / nloc;
        if (old + 1u == (gen + 1u) * nloc) {
            __builtin_amdgcn_fence(__ATOMIC_RELEASE, "agent");
            asm volatile("s_waitcnt vmcnt(0)" ::: "memory");
            const unsigned og = xb_add(&bar[XB_TOP], 1u);
            const unsigned tg = og / nx;
            if (og + 1u == (tg + 1u) * nx) xb_add(&bar[XB_TOPGEN], 1u);
            else XB_SPIN(xb_ld(&bar[XB_TOPGEN]) == tg, bar);
            __builtin_amdgcn_fence(__ATOMIC_ACQUIRE, "agent");
            xb_add(&bar[XB_XGEN(b.x)], 1u);
            asm volatile("s_waitcnt vmcnt(0)" ::: "memory");
        } else {
            XB_SPIN(xb_ld(&bar[XB_XGEN(b.x)]) == gen, bar);
            __builtin_amdgcn_fence(__ATOMIC_ACQUIRE, "agent");
            asm volatile("s_waitcnt vmcnt(0)" ::: "memory");
        }
    }
    __syncthreads();
}

constexpr int NPHASE = 8;
__global__ void __launch_bounds__(512, 2) mk_fwd(Params P) {
    extern __shared__ __attribute__((aligned(16))) unsigned char lds_raw[];
    LAS unsigned char* lds = (LAS unsigned char*)lds_raw;
    cg::grid_group grid = cg::this_grid();
    unsigned char* ws = P.ws;
    const int G = gridDim.x, bx = blockIdx.x;
    const int lo = P.ph_lo, hi = P.ph_hi;
    volatile LAS unsigned* bst = (volatile LAS unsigned*)(lds + LDS_BARST);
    if (threadIdx.x < 2) bst[threadIdx.x] = 0u;
    __syncthreads();
    (void)xcd_barrier_post((unsigned*)(ws + WS_BAR) + P.pad * 4096, bst);
#if 1
    if (P.ph_lo < 0) grid.sync();
#endif
#ifndef SUBM
#define SUBM 31
#endif
#ifndef PH_MASK
#define PH_MASK 0xff
#endif
#define IN(k) (((PH_MASK >> (k)) & 1) && lo <= (k) && (k) < hi)
#define SEAM(k) do { if (IN(k) && IN((k) + 1)) { { XcdBarrier xb_; xb_.bar = (unsigned*)(ws + WS_BAR) + P.pad * 4096; xb_.x = xb_xcc_id(); xb_.st = (volatile LAS unsigned*)(lds + LDS_BARST); xcd_barrier(xb_); } } } while (0)
    if (IN(0)) { phase_prep(P, lds); __syncthreads(); }
    SEAM(0);
#ifdef EXTRA_SYNCS
    for (int i = 0; i < EXTRA_SYNCS; ++i) SEAM(0);
#endif
    if (IN(1)) {
        { pg8::GemmStd g{(const bf16_t*)P.out, (const bf16_t*)(ws + WS_W1T), 1024};
#define EPI_IN_ARGS (bf16_t*)(ws + WS_CONV), (bf16_t*)(ws + WS_QK), (bf16_t*)(ws + WS_VT), (bf16_t*)(ws + WS_QM), (bf16_t*)(ws + WS_GATES), P.b_gate, P.moba_qg, P.moba_kg, (float*)(ws + WS_KBAR)
          if (SUBM & 2) { SubOrder S; S.base.init(T_TOK, 4 * 256, G, bx); S.split = 4; S.off0 = 6; S.off1 = 0; EpiIn<1> E{EPI_IN_ARGS};
            pg8::gemm_phase<EpiIn<1>, SubOrder, pg8::GemmStd, true, true>(lds, g, S, E); }
          if (SUBM & 4) { pg8::GemmStd gv{(const bf16_t*)(ws + WS_W1T) + (size_t)2560 * 1024, (const bf16_t*)P.out, 1024};
            pg8::StaticOrder S; S.init(512, T_TOK, G, bx); EpiVT E{(bf16_t*)(ws + WS_VT)};
            pg8::gemm_phase<EpiVT, pg8::StaticOrder, pg8::GemmStd, true, true>(lds, gv, S, E); }
          if (SUBM & 1) { SubOrder S; S.base.init(T_TOK, 8 * 256, G, bx); S.split = 6; S.off0 = 0; S.off1 = 12; EpiIn<0> E{EPI_IN_ARGS};
            pg8::gemm_phase<EpiIn<0>, SubOrder, pg8::GemmStd, true, true>(lds, g, S, E); }
          if (SUBM & 8) { SubOrder S; S.base.init(T_TOK, 12 * 256, G, bx); S.split = 12; S.off0 = 14; S.off1 = 0; EpiIn<3> E{EPI_IN_ARGS};
            pg8::gemm_phase<EpiIn<3>, SubOrder, pg8::GemmStd, true, true>(lds, g, S, E); }
#undef EPI_IN_ARGS
        }
        if (SUBM & 16) { pg8::GemmStd g{(const bf16_t*)(ws + WS_MEMB), (const bf16_t*)(ws + WS_WKVT), 1024}; pg8::StaticOrder S; S.init(MEMT, 1024, G, bx);
          EpiMemKV E{(bf16_t*)(ws + WS_MEMK), (bf16_t*)(ws + WS_MEMVT)};
          pg8::gemm_phase<EpiMemKV, pg8::StaticOrder, pg8::GemmStd, true, true>(lds, g, S, E); }
    }
    SEAM(1);
    if (IN(2)) { phase_mixers(P, lds); __syncthreads(); }
    SEAM(2);
    if (IN(3)) {
        const bf16_t* y = (const bf16_t*)P.out;
        pg8::GemmSeg3 g{y, y + (size_t)T_TOK * 512, y + (size_t)T_TOK * 1024, (const bf16_t*)(ws + WS_WBRT), 512};
        SegOrder S; S.base.init(T_TOK, 1024, G, bx);
        EpiMerge E{(const bf16_t*)(ws + WS_GATES), (bf16_t*)(ws + WS_MERGED)};
        pg8::gemm_phase<EpiMerge, SegOrder, pg8::GemmSeg3, true, true>(lds, g, S, E);
    }
    SEAM(3);
    if (IN(4)) {
        pg8::GemmStd g{(const bf16_t*)(ws + WS_MERGED), (const bf16_t*)(ws + WS_WOT), 1024}; pg8::StaticOrder S; S.init(T_TOK, 1024, G, bx);
        EpiWo E{P.x, P.out, (bf16_t*)(ws + WS_X1B), (float*)(ws + WS_SSQ)};
        pg8::gemm_phase<EpiWo, pg8::StaticOrder, pg8::GemmStd, true, true>(lds, g, S, E);
    }
    SEAM(4);
    if (IN(5)) {
        pg8::GemmStd g{(const bf16_t*)(ws + WS_X1B), (const bf16_t*)(ws + WS_WUPT), 1024}; pg8::StaticOrder S; S.init(T_TOK, 2 * DFF, G, bx);
        EpiUp E{(const float*)(ws + WS_SSQ), (bf16_t*)(ws + WS_BU), (float*)(ws + WS_AR), P.ffn_conv_w, P.ffn_conv_b};
        pg8::gemm_phase<EpiUp, pg8::StaticOrder, pg8::GemmStd, true, true>(lds, g, S, E);
    }
    SEAM(5);
    if (IN(6)) phase_ffn_fix(P);
    SEAM(6);
    if (IN(7)) {
        pg8::GemmStd g{(const bf16_t*)(ws + WS_BU), (const bf16_t*)(ws + WS_WDNT), DFF}; pg8::StaticOrder S; S.init(T_TOK, 1024, G, bx);
        EpiDown E{P.out};
        pg8::gemm_phase<EpiDown, pg8::StaticOrder, pg8::GemmStd, true, true>(lds, g, S, E);
    }
#undef IN
#undef SEAM
}

#if defined(__HIP_DEVICE_COMPILE__)
#pragma clang attribute pop
#endif
extern "C" void kernel_launch(void* const* d_in, const int* in_sizes, int n_in, void* d_out, int out_size, void* d_ws, size_t ws_size, hipStream_t stream) {
    static int grid = 0;
    if (grid == 0) {
        if (n_in != 22 || in_sizes[0] != T_TOK * DM || out_size != T_TOK * DM || ws_size < WS_NEED) {
            fprintf(stderr, "kernel_launch: unexpected shapes: n_in %d in0 %d out %d ws %zu (need %zu)\n", n_in, n_in > 0 ? in_sizes[0] : -1, out_size, ws_size, (size_t)WS_NEED); grid = -1; return; }
        int dev = 0, cus = 0, per_cu = 0;
        (void)hipGetDevice(&dev); (void)hipDeviceGetAttribute(&cus, hipDeviceAttributeMultiprocessorCount, dev);
        if (hipFuncSetAttribute((const void*)mk_fwd, hipFuncAttributeMaxDynamicSharedMemorySize, LDS_BYTES) != hipSuccess) { fprintf(stderr, "kernel_launch: hipFuncSetAttribute failed\n"); grid = -1; return; }
        if (hipOccupancyMaxActiveBlocksPerMultiprocessor(&per_cu, (const void*)mk_fwd, 512, LDS_BYTES) != hipSuccess || per_cu < 1) { fprintf(stderr, "kernel_launch: occupancy query says %d\n", per_cu); per_cu = 1; }
        (void)hipGetLastError();
        grid = cus * per_cu;
    }
    if (grid < 0) return;
    if (hipMemsetAsync((char*)d_ws + WS_BAR, 0, 4 * 16384, stream) != hipSuccess) { fprintf(stderr, "kernel_launch: memset of the barrier words failed\n"); return; }
    Params p{};
    const float** pp = (const float**)&p;
    for (int i = 0; i < 22; ++i) pp[i] = (const float*)d_in[i];
    p.out = (float*)d_out; p.ws = (unsigned char*)d_ws;
#ifdef MK_RANGES
    { const int rg[][3] = MK_RANGES;
      for (unsigned k = 0; k < sizeof(rg) / sizeof(rg[0]); ++k) { p.ph_lo = rg[k][0]; p.ph_hi = rg[k][1]; p.sub = rg[k][2]; p.pad = (int)k; void* args[] = {&p};
        hipError_t e = hipLaunchCooperativeKernel((const void*)mk_fwd, dim3(grid), dim3(512), args, LDS_BYTES, stream);
        if (e != hipSuccess) { fprintf(stderr, "launch %u failed: %s\n", k, hipGetErrorString(e)); break; } } }
#else
    p.ph_lo = 0; p.ph_hi = NPHASE; p.sub = 7; void* args[] = {&p};
    hipError_t e = hipLaunchCooperativeKernel((const void*)mk_fwd, dim3(grid), dim3(512), args, LDS_BYTES, stream);
    if (e != hipSuccess) fprintf(stderr, "cooperative launch failed: %s (grid %d)\n", hipGetErrorString(e), grid);
#endif
}
```

```cpp
#if defined(__HIP_DEVICE_COMPILE__)
#pragma clang attribute push(__attribute__((target("no-packed-fp32-ops"))), apply_to = function)
#endif
#include <hip/hip_runtime.h>
#include <hip/hip_cooperative_groups.h>
#include <cstdio>
#include <cstdint>
namespace cg = cooperative_groups;

#define LAS __attribute__((address_space(3)))
typedef unsigned short bf16_t;
typedef short bf16x8 __attribute__((ext_vector_type(8)));
typedef float f32x4 __attribute__((ext_vector_type(4)));
typedef float f32x16 __attribute__((ext_vector_type(16)));
typedef unsigned u32x4 __attribute__((ext_vector_type(4)));
typedef unsigned u32x2 __attribute__((ext_vector_type(2)));
typedef float f32x2 __attribute__((ext_vector_type(2)));

constexpr int T_TOK = 65536, DM = 1024, SEQ = 4096, NBATCH = 16, NBLK = 16, INC = 6656, DFF = 2816, MEMT = 4096;
constexpr float EPS = 1e-6f;
constexpr float LOG2E = 1.4426950408889634f;
constexpr float C2_MOBA = 0.125f * LOG2E;
constexpr float C2_MEM = 0.08838834764831845f * LOG2E;

__device__ __forceinline__ unsigned cvt_pk_bf16(float lo, float hi) { unsigned r; asm volatile("v_cvt_pk_bf16_f32 %0, %1, %2" : "=v"(r) : "v"(lo), "v"(hi)); return r; }
__device__ __forceinline__ unsigned cvt_pk_bf16_t(float lo, float hi) { unsigned r; asm volatile("s_nop 1\n\tv_cvt_pk_bf16_f32 %0, %1, %2" : "=v"(r) : "v"(lo), "v"(hi)); return r; }
__device__ __forceinline__ float bf_lo(unsigned w) { return __uint_as_float(w << 16); }
__device__ __forceinline__ float bf_hi(unsigned w) { return __uint_as_float(w & 0xffff0000u); }
__device__ __forceinline__ u32x4 pack8(f32x4 a, f32x4 b) { u32x4 w; w.x = cvt_pk_bf16(a[0], a[1]); w.y = cvt_pk_bf16(a[2], a[3]); w.z = cvt_pk_bf16(b[0], b[1]); w.w = cvt_pk_bf16(b[2], b[3]); return w; }
__device__ __forceinline__ u32x4 pack8t(f32x4 a, f32x4 b) { u32x4 w; w.x = cvt_pk_bf16_t(a[0], a[1]); w.y = cvt_pk_bf16_t(a[2], a[3]); w.z = cvt_pk_bf16_t(b[0], b[1]); w.w = cvt_pk_bf16_t(b[2], b[3]); return w; }
__device__ __forceinline__ void unpack8(u32x4 w, f32x4& a, f32x4& b) { a = (f32x4){bf_lo(w.x), bf_hi(w.x), bf_lo(w.y), bf_hi(w.y)}; b = (f32x4){bf_lo(w.z), bf_hi(w.z), bf_lo(w.w), bf_hi(w.w)}; }
__device__ __forceinline__ float fast_sigmoid(float x) { return __builtin_amdgcn_rcpf(1.0f + __builtin_amdgcn_exp2f(x * -LOG2E)); }

struct Params {
    const float* x; const float* mem; const float* g_mix; const float* w_in; const float* b_gate; const float* conv_w; const float* conv_b;
    const float* moba_qg; const float* moba_kg; const float* g_mem; const float* w_mem_kv; const float* memq_g; const float* memk_g;
    const float* w_br_conv; const float* w_br_moba; const float* w_br_mem; const float* w_o; const float* g_ffn; const float* w_up;
    const float* ffn_conv_w; const float* ffn_conv_b; const float* w_down;
    float* out; unsigned char* ws;
    int ph_lo, ph_hi, sub, pad;
};

constexpr size_t MiB = 1u << 20;
constexpr size_t WS_KBAR = 0;
constexpr size_t WS_BAR = 768 * 1024;
constexpr size_t WS_SSQ = 1 * MiB;
constexpr size_t WS_W1T = 5 * MiB;
constexpr size_t WS_WKVT = 18 * MiB;
constexpr size_t WS_WBRT = 20 * MiB;
constexpr size_t WS_WOT = 23 * MiB;
constexpr size_t WS_WUPT = 25 * MiB;
constexpr size_t WS_WDNT = 36 * MiB;
constexpr size_t WS_MEMB = 42 * MiB;
constexpr size_t WS_MEMK = 50 * MiB;
constexpr size_t WS_MEMVT = 54 * MiB;
constexpr size_t WS_VT = 64 * MiB;
constexpr size_t WS_CONV = 128 * MiB;
constexpr size_t WS_QK = 320 * MiB;
constexpr size_t WS_QM = 448 * MiB;
constexpr size_t WS_GATES = 512 * MiB;
constexpr size_t WS_MERGED = 64 * MiB;
constexpr size_t WS_X1B = 192 * MiB;
constexpr size_t WS_AR = 320 * MiB;
constexpr size_t WS_BU = 672 * MiB;
constexpr size_t WS_NEED = 1024 * MiB;

constexpr int LDS_BYTES = 147456;
constexpr int LDS_BARST = LDS_BYTES - 64;

namespace pg8 {
#define PG8_LAS __attribute__((address_space(3)))
constexpr int BM = 256, BK = 64, HALF = 128, HTB = HALF * BK * 2  , STAGE_BYTES = 8 * HTB, NXCD = 8, WGM = 8;

__host__ __device__ __forceinline__ int lds_byte(int r, int c) { const int st = (r >> 4) * 2 + (c >> 5), rr = r & 15, cc = c & 31, ob = rr * 64 + cc * 2; return st * 1024 + (ob ^ (((ob >> 9) & 1) << 5)); }
__host__ __device__ __forceinline__ void stage_rc(int b, int& R, int& C) { const int st = b / 1024, sb = b % 1024, swz = sb ^ (((sb >> 9) & 1) << 5); R = (st >> 1) * 16 + swz / 64; C = (st & 1) * 32 + (swz % 64) / 2; }
__host__ __device__ __forceinline__ int perm32(int rho) { const int n = rho >> 4, i = rho & 15; return 8 * (i >> 2) + 4 * n + (i & 3); }

struct Unit { int pm, pn, seg; };
struct GemmStd { const bf16_t* A; const bf16_t* Bt; int K;
    __device__ __forceinline__ const char* a_ptr(const Unit& u) const { return (const char*)A + (size_t)u.pm * 512 * K; }
    __device__ __forceinline__ const char* b_ptr(const Unit& u) const { return (const char*)Bt + (size_t)u.pn * 512 * K; } };
struct GemmSeg3 { const bf16_t* A0; const bf16_t* A1; const bf16_t* A2; const bf16_t* Bt; int K;
    __device__ __forceinline__ const char* a_ptr(const Unit& u) const { const bf16_t* a = u.seg == 0 ? A0 : (u.seg == 1 ? A1 : A2); return (const char*)a + (size_t)u.pm * 512 * K; }
    __device__ __forceinline__ const char* b_ptr(const Unit& u) const { return (const char*)Bt + (size_t)u.seg * 1024 * K * 2 + (size_t)u.pn * 512 * K; } };

struct StaticOrder {
    int nM, nN, nwg, G, c;
    __host__ __device__ void init(int M, int N, int G_, int c_) { nM = M / BM; nN = N / BM; nwg = nM * nN; G = G_; c = c_; }
    __host__ __device__ bool next(int i, Unit& u) const {
        const long L = (long)i * G + c; if (L >= nwg) return false;
        int wgid = (int)L; { const int q = nwg / NXCD, r = nwg % NXCD, xcd = wgid % NXCD, off = wgid / NXCD; wgid = (xcd < r ? xcd * (q + 1) : r * (q + 1) + (xcd - r) * q) + off; }
        const int nig = WGM * nN, gid = wgid / nig, fm = gid * WGM, gsz = (nM - fm) < WGM ? (nM - fm) : WGM;
        u.pm = fm + ((wgid % nig) % gsz); u.pn = (wgid % nig) / gsz; u.seg = 0; return true;
    }
    __device__ __forceinline__ void a_ready(const Unit&) const {}
    __device__ __forceinline__ void done(const Unit&) const {}
};

template <class Epi, class Sched, class GemmT, bool ALIGN_EPI = false, bool SP2 = false>
__device__ __forceinline__ void gemm_phase(PG8_LAS unsigned char* lds, const GemmT g, const Sched& S, const Epi& E) {
    int tid = threadIdx.x; asm volatile("" : "+v"(tid));
    const int wid = __builtin_amdgcn_readfirstlane(tid >> 6), lane = tid & 63, wr = wid >> 2, wc = wid & 3, fr = lane & 15, fq = lane >> 4;
    const int K = g.K, nt = K / BK;
    unsigned voffA[2], voffB[2];
#pragma unroll
    for (int i = 0; i < 2; ++i) { int R, C; stage_rc(tid * 16 + i * 8192, R, C); const int Rb = Epi::PERM ? ((R & ~31) + perm32(R & 31)) : R;
        voffA[i] = (unsigned)(R * K + C) * 2u; voffB[i] = (unsigned)(Rb * K + C) * 2u; }
    const size_t kstep = (size_t)(BK * 2);
    const size_t hstep = (size_t)HALF * K * 2;

    const unsigned ldsw = (unsigned)wid * 1024u;
    const int aoff = lds_byte(wr * 64 + fr, fq * 8), boff = lds_byte(wc * 32 + fr, fq * 8);
#define PG8_SA(b, h) (((b) * 2 + (h)) * HTB)
#define PG8_SB(b, h) ((4 + (b) * 2 + (h)) * HTB)
#define PG8_STAGE(bufoff, gbase, voff) do { _Pragma("unroll") for (int _i = 0; _i < 2; ++_i) \
        __builtin_amdgcn_global_load_lds((const unsigned*)((const char*)(gbase) + (voff)[_i]), (PG8_LAS unsigned*)(lds + (bufoff) + ldsw + _i * 8192), 16, 0, 0); } while (0)
#define PG8_LDA(dst, b, h) do { _Pragma("unroll") for (int m = 0; m < 4; ++m) _Pragma("unroll") for (int k = 0; k < 2; ++k) dst[m][k] = *(const PG8_LAS bf16x8*)(lds + PG8_SA(b, h) + aoff + m * 2048 + k * 1024); } while (0)
#define PG8_LDB(dst, b, h) do { _Pragma("unroll") for (int n = 0; n < 2; ++n) _Pragma("unroll") for (int k = 0; k < 2; ++k) dst[n][k] = *(const PG8_LAS bf16x8*)(lds + PG8_SB(b, h) + boff + n * 2048 + k * 1024); } while (0)
#define PG8_MMA(ai, bj, At, Bt) do { __builtin_amdgcn_s_setprio(1); _Pragma("unroll") for (int m = 0; m < 4; ++m) _Pragma("unroll") for (int n = 0; n < 2; ++n) _Pragma("unroll") for (int k = 0; k < 2; ++k) \
        acc[ai][bj][m][n] = __builtin_amdgcn_mfma_f32_16x16x32_bf16(Bt[n][k], At[m][k], acc[ai][bj][m][n], 0, 0, 0); __builtin_amdgcn_s_setprio(0); } while (0)
#define PG8_WAIT_V(n) asm volatile("s_waitcnt vmcnt(" #n ")" ::: "memory")
#define PG8_WAIT_L(n) asm volatile("s_waitcnt lgkmcnt(" #n ")" ::: "memory")
#define PG8_BAR __builtin_amdgcn_s_barrier()
#define PG8_SCHED __builtin_amdgcn_sched_barrier(0)
    Unit cur, nxt; int ui = 0;
    if (!S.next(0, cur)) return;
    f32x4 acc[2][2][4][2];
#pragma unroll
    for (int a = 0; a < 2; ++a)
#pragma unroll
        for (int b = 0; b < 2; ++b)
#pragma unroll
            for (int m = 0; m < 4; ++m)
#pragma unroll
                for (int n = 0; n < 2; ++n) acc[a][b][m][n] = (f32x4){0.f, 0.f, 0.f, 0.f};
    bf16x8 At[4][2], B0[2][2], B1[2][2];
    const char* cA = g.a_ptr(cur); const char* cB = g.b_ptr(cur);
    S.a_ready(cur);
    if constexpr (SP2) {
        PG8_STAGE(PG8_SB(0, 0), cB, voffB); PG8_STAGE(PG8_SB(0, 1), cB + hstep, voffB); PG8_STAGE(PG8_SA(0, 0), cA, voffA); PG8_STAGE(PG8_SA(0, 1), cA + hstep, voffA);
        if (wr == 1) PG8_BAR;
        PG8_WAIT_V(2); PG8_BAR;
        PG8_STAGE(PG8_SB(1, 0), cB + kstep, voffB); PG8_STAGE(PG8_SA(1, 0), cA + kstep, voffA); PG8_STAGE(PG8_SB(1, 1), cB + hstep + kstep, voffB);
        PG8_WAIT_V(6); PG8_BAR;
    } else {
        PG8_STAGE(PG8_SB(0, 0), cB, voffB); PG8_STAGE(PG8_SA(0, 0), cA, voffA); PG8_STAGE(PG8_SB(0, 1), cB + hstep, voffB); PG8_STAGE(PG8_SA(0, 1), cA + hstep, voffA);
        if (wr == 1) PG8_BAR;
        PG8_WAIT_V(4); PG8_BAR;
        PG8_STAGE(PG8_SB(1, 0), cB + kstep, voffB); PG8_STAGE(PG8_SA(1, 0), cA + kstep, voffA); PG8_STAGE(PG8_SB(1, 1), cB + hstep + kstep, voffB);
        PG8_WAIT_V(6); PG8_BAR;
    }
    for (;;) {
        const bool has_next = S.next(ui + 1, nxt);
        const char* nA = has_next ? g.a_ptr(nxt) : cA; const char* nB = has_next ? g.b_ptr(nxt) : cB;
        for (int t = 0; t < nt; t += 2) {
            const bool last = (t == nt - 2);
            const char* a1 = cA + (size_t)(t + 1) * kstep;
            const char* a2 = last ? nA : cA + (size_t)(t + 2) * kstep; const char* b2 = last ? nB : cB + (size_t)(t + 2) * kstep;
            const char* a3 = a2 + kstep; const char* b3 = b2 + kstep;
            if (last && has_next) S.a_ready(nxt);
            if constexpr (SP2) {
            PG8_LDB(B0, 0, 0); PG8_LDB(B1, 0, 1); PG8_SCHED; PG8_LDA(At, 0, 0); PG8_STAGE(PG8_SA(1, 1), a1 + hstep, voffA);
            PG8_WAIT_V(8); PG8_WAIT_L(0); PG8_BAR; PG8_MMA(0, 0, At, B0); PG8_MMA(0, 1, At, B1); PG8_BAR; PG8_SCHED;
            PG8_LDA(At, 0, 1); PG8_STAGE(PG8_SB(0, 0), b2, voffB); PG8_STAGE(PG8_SB(0, 1), b2 + hstep, voffB); PG8_STAGE(PG8_SA(0, 0), a2, voffA);
            PG8_WAIT_V(8); PG8_WAIT_L(0); PG8_BAR; PG8_MMA(1, 0, At, B0); PG8_MMA(1, 1, At, B1); PG8_BAR; PG8_SCHED;
            PG8_LDB(B0, 1, 0); PG8_LDB(B1, 1, 1); PG8_SCHED; PG8_LDA(At, 1, 0); PG8_STAGE(PG8_SA(0, 1), a2 + hstep, voffA);
            PG8_WAIT_V(8); PG8_WAIT_L(0); PG8_BAR; PG8_MMA(0, 0, At, B0); PG8_MMA(0, 1, At, B1); PG8_BAR; PG8_SCHED;
            PG8_LDA(At, 1, 1); PG8_STAGE(PG8_SB(1, 0), b3, voffB); PG8_STAGE(PG8_SB(1, 1), b3 + hstep, voffB); PG8_STAGE(PG8_SA(1, 0), a3, voffA);
            PG8_WAIT_V(8); PG8_WAIT_L(0); PG8_BAR; PG8_MMA(1, 0, At, B0); PG8_MMA(1, 1, At, B1); PG8_BAR; PG8_SCHED;
            } else {
            PG8_LDB(B0, 0, 0); PG8_SCHED; PG8_LDA(At, 0, 0); PG8_STAGE(PG8_SA(1, 1), a1 + hstep, voffA);
            PG8_WAIT_L(8); PG8_BAR; PG8_WAIT_L(0); PG8_MMA(0, 0, At, B0); PG8_BAR; PG8_SCHED;
            PG8_LDB(B1, 0, 1); PG8_STAGE(PG8_SB(0, 0), b2, voffB);
            PG8_BAR; PG8_WAIT_L(0); PG8_MMA(0, 1, At, B1); PG8_BAR;
            PG8_LDA(At, 0, 1); PG8_STAGE(PG8_SA(0, 0), a2, voffA);
            PG8_BAR; PG8_WAIT_L(0); PG8_MMA(1, 0, At, B0); PG8_BAR; PG8_SCHED;
            PG8_STAGE(PG8_SB(0, 1), b2 + hstep, voffB);
            PG8_WAIT_V(6); PG8_BAR; PG8_MMA(1, 1, At, B1); PG8_BAR;
            PG8_LDB(B0, 1, 0); PG8_SCHED; PG8_LDA(At, 1, 0); PG8_STAGE(PG8_SA(0, 1), a2 + hstep, voffA);
            PG8_WAIT_L(8); PG8_BAR; PG8_WAIT_L(0); PG8_MMA(0, 0, At, B0); PG8_BAR; PG8_SCHED;
            PG8_LDB(B1, 1, 1); PG8_STAGE(PG8_SB(1, 0), b3, voffB);
            PG8_BAR; PG8_WAIT_L(0); PG8_MMA(0, 1, At, B1); PG8_BAR;
            PG8_LDA(At, 1, 1); PG8_STAGE(PG8_SA(1, 0), a3, voffA);
            PG8_BAR; PG8_WAIT_L(0); PG8_MMA(1, 0, At, B0); PG8_BAR; PG8_SCHED;
            PG8_STAGE(PG8_SB(1, 1), b3 + hstep, voffB);
            PG8_WAIT_V(6); PG8_BAR; PG8_MMA(1, 1, At, B1); PG8_BAR;
            }
        }
        if constexpr (ALIGN_EPI) { if (wr == 0) PG8_BAR; }
        if constexpr (!Epi::AFTER_DRAIN) { E(acc, cur, wr, wc, fr, fq); S.done(cur); }
        if (!has_next) break;
        if (Epi::zero_after(cur))
#pragma unroll
        for (int a = 0; a < 2; ++a)
#pragma unroll
            for (int b = 0; b < 2; ++b)
#pragma unroll
                for (int m = 0; m < 4; ++m)
#pragma unroll
                    for (int n = 0; n < 2; ++n) acc[a][b][m][n] = (f32x4){0.f, 0.f, 0.f, 0.f};
        cur = nxt; cA = nA; cB = nB; ++ui;
        if constexpr (ALIGN_EPI) { if (wr == 1) PG8_BAR; }
    }
    PG8_WAIT_V(0);
    if constexpr (!ALIGN_EPI) { if (wr == 0) PG8_BAR; }
    PG8_BAR;
    if constexpr (Epi::AFTER_DRAIN) { E.fused(acc, cur, wr, wc, fr, fq, lds, wid, lane); S.done(cur); }
#undef PG8_SA
#undef PG8_SB
#undef PG8_STAGE
#undef PG8_LDA
#undef PG8_LDB
#undef PG8_MMA
#undef PG8_WAIT_V
#undef PG8_WAIT_L
#undef PG8_BAR
#undef PG8_SCHED
}
}

using pg8::Unit;
struct SegOrder {
    pg8::StaticOrder base;
    __device__ bool next(int i, Unit& u) const { const int q = i / 3; if (!base.next(q, u)) return false; u.seg = i - 3 * q; return true; }
    __device__ __forceinline__ void a_ready(const Unit&) const {}
    __device__ __forceinline__ void done(const Unit&) const {}
};

struct SubOrder {
    pg8::StaticOrder base; int split, off0, off1;
    __device__ bool next(int i, Unit& u) const { if (!base.next(i, u)) return false; u.pn = u.pn < split ? off0 + u.pn : off1 + (u.pn - split); return true; }
    __device__ __forceinline__ void a_ready(const Unit&) const {}
    __device__ __forceinline__ void done(const Unit&) const {}
};

#define ACC_T f32x4 (&acc)[2][2][4][2]

template <int KIND  > struct EpiIn {
    static constexpr bool PERM = true, AFTER_DRAIN = false;
    static __device__ __forceinline__ bool zero_after(const Unit&) { return true; }
    bf16_t* convb; bf16_t* qk; bf16_t* vT; bf16_t* qm; bf16_t* gates; const float* bgate; const float* qg; const float* kg; float* kbar;
    __device__ __forceinline__ void operator()(ACC_T, const Unit& u, int wr, int wc, int fr, int fq) const {
        const int pn = u.pn;
        const int lc = 64 * wc + 8 * fq;
        const int row0 = u.pm * 256 + wr * 64 + fr;
        if constexpr (KIND == 0) {
            bf16_t* base; int ld, c0;
            asm volatile("" ::: "memory");
            if (pn < 6) { base = convb; ld = 1536; c0 = pn * 256; } else { base = qm; ld = 512; c0 = (pn - 12) * 256; }
#pragma unroll
            for (int ai = 0; ai < 2; ++ai)
#pragma unroll
                for (int m = 0; m < 4; ++m) { const int row = row0 + ai * 128 + m * 16;
#pragma unroll
                    for (int bj = 0; bj < 2; ++bj) *(u32x4*)(base + (size_t)row * ld + c0 + lc + 32 * bj) = pack8(acc[ai][bj][m][0], acc[ai][bj][m][1]); }
        } else if constexpr (KIND == 1) {
            asm volatile("" ::: "memory");
            const bool isk = pn >= 8; const int hl = (pn & 1) * 4 + wc;
            const float* gp = isk ? kg : qg; const float gs = isk ? 1.0f : C2_MOBA;
#pragma unroll
            for (int ai = 0; ai < 2; ++ai)
#pragma unroll
                for (int m = 0; m < 4; ++m) { const int row = row0 + ai * 128 + m * 16;
                    float ss = 0.f;
#pragma unroll
                    for (int bj = 0; bj < 2; ++bj)
#pragma unroll
                        for (int n = 0; n < 2; ++n) { const f32x4 q = acc[ai][bj][m][n] * acc[ai][bj][m][n]; ss += (q[0] + q[1]) + (q[2] + q[3]); }
                    ss += __shfl_xor(ss, 16); ss += __shfl_xor(ss, 32);
                    const float r = rsqrtf(ss * (1.0f / 64.0f) + EPS) * gs;
#pragma unroll
                    for (int bj = 0; bj < 2; ++bj) { asm volatile("" ::: "memory"); const f32x4 g0 = *(const f32x4*)(gp + 32 * bj + 8 * fq), g1 = *(const f32x4*)(gp + 32 * bj + 8 * fq + 4);
                        acc[ai][bj][m][0] = acc[ai][bj][m][0] * r * g0; acc[ai][bj][m][1] = acc[ai][bj][m][1] * r * g1;
                        *(u32x4*)(qk + (size_t)row * 1024 + (isk ? 512 : 0) + hl * 64 + 32 * bj + 8 * fq) = pack8(acc[ai][bj][m][0], acc[ai][bj][m][1]); }
                    __builtin_amdgcn_sched_barrier(0);
                }
            if (isk) {
#pragma unroll
                for (int bj = 0; bj < 2; ++bj)
#pragma unroll
                    for (int n = 0; n < 2; ++n) { f32x4 c4 = acc[0][bj][0][n];
#pragma unroll
                        for (int ai = 0; ai < 2; ++ai)
#pragma unroll
                            for (int m = 0; m < 4; ++m) if (ai + m > 0) c4 = c4 + acc[ai][bj][m][n];
#pragma unroll
                        for (int e = 0; e < 4; ++e) { float sm = c4[e]; sm += __shfl_xor(sm, 1); sm += __shfl_xor(sm, 2); sm += __shfl_xor(sm, 4); sm += __shfl_xor(sm, 8);
                            if (fr == 0) atomicAdd(kbar + ((size_t)((u.pm >> 4) * 8 + hl) * 16 + (u.pm & 15)) * 64 + 32 * bj + 8 * fq + 4 * n + e, sm); } }
            }
        } else if constexpr (KIND == 2) {
            asm volatile("" ::: "memory");
            const int hl = (pn & 1) * 4 + wc; const int b = u.pm >> 4; const int s0 = (u.pm & 15) * 256 + wr * 64 + fr;
            bf16_t* vb = vT + ((size_t)(b * 8 + hl) * 64 + 8 * fq) * 4096 + s0;
#pragma unroll
            for (int ai = 0; ai < 2; ++ai)
#pragma unroll
                for (int m = 0; m < 4; ++m) {
#pragma unroll
                    for (int bj = 0; bj < 2; ++bj)
#pragma unroll
                        for (int n = 0; n < 2; ++n) { const f32x4 v = acc[ai][bj][m][n]; const unsigned w0 = cvt_pk_bf16(v[0], v[1]), w1 = cvt_pk_bf16(v[2], v[3]);
                            bf16_t* p = vb + (size_t)(32 * bj + 4 * n) * 4096 + ai * 128 + m * 16;
                            p[0] = (bf16_t)(w0 & 0xffffu); p[4096] = (bf16_t)(w0 >> 16); p[2 * 4096] = (bf16_t)(w1 & 0xffffu); p[3 * 4096] = (bf16_t)(w1 >> 16); }
                }
        } else {
            asm volatile("" ::: "memory");
            const int gc = (pn - 14) * 256 + lc;
            f32x4 bb[2][2];
#pragma unroll
            for (int bj = 0; bj < 2; ++bj)
#pragma unroll
                for (int n = 0; n < 2; ++n) bb[bj][n] = *(const f32x4*)(bgate + gc + 32 * bj + 4 * n);
#pragma unroll
            for (int ai = 0; ai < 2; ++ai)
#pragma unroll
                for (int m = 0; m < 4; ++m) { const int row = row0 + ai * 128 + m * 16;
#pragma unroll
                    for (int bj = 0; bj < 2; ++bj) { f32x4 v0 = acc[ai][bj][m][0] + bb[bj][0], v1 = acc[ai][bj][m][1] + bb[bj][1];
#pragma unroll
                        for (int e = 0; e < 4; ++e) { v0[e] = fast_sigmoid(v0[e]); v1[e] = fast_sigmoid(v1[e]); }
                        *(u32x4*)(gates + (size_t)row * 3072 + gc + 32 * bj) = pack8t(v0, v1); }
                }
        }
    }
};

struct EpiVT {
    static constexpr bool PERM = true, AFTER_DRAIN = false;
    static __device__ __forceinline__ bool zero_after(const Unit&) { return true; }
    bf16_t* vT;
    __device__ __forceinline__ void operator()(ACC_T, const Unit& u, int wr, int wc, int fr, int fq) const {
        const int tok0 = u.pn * 256 + 32 * wc + 8 * fq;
        const int b = u.pn >> 4, s0 = tok0 & (SEQ - 1);
#pragma unroll
        for (int ai = 0; ai < 2; ++ai)
#pragma unroll
            for (int m = 0; m < 4; ++m) { const int rl = 128 * ai + 64 * wr + 16 * m + fr;
                const int dorig = 64 * ((rl & 127) >> 5) + 32 * (rl >> 7) + (rl & 31);
                const int h = u.pm * 4 + (dorig >> 6), d = dorig & 63;
                bf16_t* p = vT + ((size_t)(b * 8 + h) * 64 + d) * 4096 + s0;
#pragma unroll
                for (int bj = 0; bj < 2; ++bj) *(u32x4*)(p + 128 * bj) = pack8(acc[ai][bj][m][0], acc[ai][bj][m][1]); }
    }
};

struct EpiMemKV {
    static constexpr bool PERM = true, AFTER_DRAIN = false;
    static __device__ __forceinline__ bool zero_after(const Unit&) { return true; }
    bf16_t* memk; bf16_t* memvT;
    __device__ __forceinline__ void operator()(ACC_T, const Unit& u, int wr, int wc, int fr, int fq) const {
        const int row0 = u.pm * 256 + wr * 64 + fr;
#pragma unroll
        for (int ai = 0; ai < 2; ++ai)
#pragma unroll
            for (int m = 0; m < 4; ++m) { const int row = row0 + ai * 128 + m * 16;
#pragma unroll
                for (int bj = 0; bj < 2; ++bj) { const int col = u.pn * 256 + 128 * bj + 32 * wc + 8 * fq;
                    if (u.pn < 2) *(u32x4*)(memk + (size_t)row * 512 + col) = pack8(acc[ai][bj][m][0], acc[ai][bj][m][1]);
                    else { const int c = col - 512, h = c >> 7, d = c & 127; bf16_t* p = memvT + ((size_t)(u.pm * 4 + h) * 128 + d) * 256 + (row & 255);
#pragma unroll
                        for (int n = 0; n < 2; ++n) { const f32x4 v = acc[ai][bj][m][n]; const unsigned w0 = cvt_pk_bf16(v[0], v[1]), w1 = cvt_pk_bf16(v[2], v[3]);
                            bf16_t* q = p + (4 * n) * 256; q[0] = (bf16_t)(w0 & 0xffffu); q[256] = (bf16_t)(w0 >> 16); q[512] = (bf16_t)(w1 & 0xffffu); q[768] = (bf16_t)(w1 >> 16); } }
                } }
    }
};

struct EpiMerge {
    static constexpr bool PERM = true, AFTER_DRAIN = false;
    static __device__ __forceinline__ bool zero_after(const Unit& u) { return u.seg == 2; }
    const bf16_t* gates; bf16_t* merged;
    __device__ __forceinline__ void operator()(ACC_T, const Unit& u, int wr, int wc, int fr, int fq) const {
        const int row0 = u.pm * 256 + wr * 64 + fr; const int seg = u.seg;
#pragma unroll
        for (int ai = 0; ai < 2; ++ai)
#pragma unroll
            for (int m = 0; m < 4; ++m) { const int row = row0 + ai * 128 + m * 16;
#pragma unroll
                for (int bj = 0; bj < 2; ++bj) { const int col = u.pn * 256 + 128 * bj + 32 * wc + 8 * fq;
                    const bf16_t* gp = gates + (size_t)row * 3072 + col;
                    f32x4 a0, a1; unpack8(*(const u32x4*)(gp + (seg == 0 ? 0 : (seg == 1 ? 1024 : 2048))), a0, a1);
                    if (seg < 2) { f32x4 d0, d1; unpack8(*(const u32x4*)(gp + (seg == 0 ? 1024 : 2048)), d0, d1);
#pragma unroll
                        for (int e = 0; e < 4; ++e) { a0[e] = a0[e] * __builtin_amdgcn_rcpf(d0[e]); a1[e] = a1[e] * __builtin_amdgcn_rcpf(d1[e]); } }
                    acc[ai][bj][m][0] = acc[ai][bj][m][0] * a0; acc[ai][bj][m][1] = acc[ai][bj][m][1] * a1;
                    if (seg == 2) *(u32x4*)(merged + (size_t)row * 1024 + col) = pack8(acc[ai][bj][m][0], acc[ai][bj][m][1]);
                } }
    }
};

struct EpiWo {
    static constexpr bool PERM = true, AFTER_DRAIN = false;
    static __device__ __forceinline__ bool zero_after(const Unit&) { return true; }
    const float* x; float* out; bf16_t* x1b; float* ssq;
    __device__ __forceinline__ void operator()(ACC_T, const Unit& u, int wr, int wc, int fr, int fq) const {
        const int row0 = u.pm * 256 + wr * 64 + fr;
#pragma unroll
        for (int ai = 0; ai < 2; ++ai)
#pragma unroll
            for (int m = 0; m < 4; ++m) { const int row = row0 + ai * 128 + m * 16; float ss = 0.f;
#pragma unroll
                for (int bj = 0; bj < 2; ++bj) { const size_t o = (size_t)row * 1024 + u.pn * 256 + 128 * bj + 32 * wc + 8 * fq;
                    const f32x4 v0 = *(const f32x4*)(x + o) + acc[ai][bj][m][0], v1 = *(const f32x4*)(x + o + 4) + acc[ai][bj][m][1];
                    *(f32x4*)(out + o) = v0; *(f32x4*)(out + o + 4) = v1; *(u32x4*)(x1b + o) = pack8(v0, v1);
                    const f32x4 q0 = v0 * v0, q1 = v1 * v1; ss += ((q0[0] + q0[1]) + (q0[2] + q0[3])) + ((q1[0] + q1[1]) + (q1[2] + q1[3])); }
                ss += __shfl_xor(ss, 16); ss += __shfl_xor(ss, 32);
                if (fq == 0) ssq[(size_t)row * 16 + u.pn * 4 + wc] = ss; }
    }
};

template <int CTRL> __device__ __forceinline__ f32x4 dpp4(f32x4 v) { f32x4 r;
#pragma unroll
    for (int e = 0; e < 4; ++e) r[e] = __int_as_float(__builtin_amdgcn_update_dpp(0, __float_as_int(v[e]), CTRL, 0xf, 0xf, true));
    return r; }
struct EpiUp {
    static constexpr bool PERM = true, AFTER_DRAIN = false;
    static __device__ __forceinline__ bool zero_after(const Unit&) { return true; }
    const float* ssq; bf16_t* u; float* halo; const float* cw; const float* cb;
    __device__ __forceinline__ void operator()(ACC_T, const Unit& un, int wr, int wc, int fr, int fq) const {
        const int row0 = un.pm * 256 + wr * 64 + fr; const int col = un.pn * 128 + 32 * wc + 8 * fq;
#pragma unroll
        for (int ai = 0; ai < 2; ++ai)
#pragma unroll
            for (int m = 0; m < 4; ++m) { const int row = row0 + ai * 128 + m * 16;
                const f32x4 s0 = *(const f32x4*)(ssq + (size_t)row * 16 + 4 * fq);
                float tot = (s0[0] + s0[1]) + (s0[2] + s0[3]); tot += __shfl_xor(tot, 16); tot += __shfl_xor(tot, 32);
                const float rs = rsqrtf(tot * (1.0f / 1024.0f) + EPS);
#pragma unroll
                for (int bj = 0; bj < 2; ++bj) { acc[ai][bj][m][0] = acc[ai][bj][m][0] * rs; acc[ai][bj][m][1] = acc[ai][bj][m][1] * rs; } }
        asm volatile("" ::: "memory");
#pragma unroll
        for (int ai = 0; ai < 2; ++ai) {
            const int grp = un.pm * 4 + ai * 2 + wr;
            float* hb = halo + (size_t)grp * 6 * DFF + col;
            if (fr >= 14) { *(f32x4*)(hb + (size_t)(fr - 14) * DFF) = acc[ai][0][3][0]; *(f32x4*)(hb + (size_t)(fr - 14) * DFF + 4) = acc[ai][0][3][1]; }
            if (fr < 2) { *(f32x4*)(hb + (size_t)(2 + fr) * DFF) = acc[ai][0][0][0]; *(f32x4*)(hb + (size_t)(2 + fr) * DFF + 4) = acc[ai][0][0][1];
                          *(f32x4*)(hb + (size_t)(4 + fr) * DFF) = acc[ai][1][0][0]; *(f32x4*)(hb + (size_t)(4 + fr) * DFF + 4) = acc[ai][1][0][1]; }
            __builtin_amdgcn_sched_barrier(0);
#pragma unroll
            for (int n = 0; n < 2; ++n) {
                const f32x4 w0 = *(const f32x4*)(cw + col + 4 * n), w1 = *(const f32x4*)(cw + DFF + col + 4 * n), w2 = *(const f32x4*)(cw + 2 * DFF + col + 4 * n), bi = *(const f32x4*)(cb + col + 4 * n);
#pragma unroll
                for (int m = 0; m < 4; ++m) { const f32x4 a = acc[ai][0][m][n]; const f32x4 ap = m > 0 ? acc[ai][0][m - 1][n] : a;
                    const f32x4 c1 = fr == 15 ? ap : a, c2 = fr >= 14 ? ap : a;
                    const f32x4 p1 = dpp4<0x121>(c1), p2 = dpp4<0x122>(c2);
                    f32x4 z = w0 * p2 + w1 * p1 + w2 * a + bi;
#pragma unroll
                    for (int e = 0; e < 4; ++e) z[e] = z[e] * fast_sigmoid(z[e]);
                    acc[ai][1][m][n] = z * acc[ai][1][m][n];
                    }
            }
#pragma unroll
            for (int m = 0; m < 4; ++m) { const int row = row0 + ai * 128 + m * 16;
                *(u32x4*)(u + (size_t)row * DFF + col)     = pack8(acc[ai][1][m][0], acc[ai][1][m][1]); }
        }
    }
};

struct EpiDown {
    static constexpr bool PERM = true, AFTER_DRAIN = false;
    static __device__ __forceinline__ bool zero_after(const Unit&) { return true; }
    float* out;
    __device__ __forceinline__ void operator()(ACC_T, const Unit& u, int wr, int wc, int fr, int fq) const {
        const int row0 = u.pm * 256 + wr * 64 + fr;
#pragma unroll
        for (int ai = 0; ai < 2; ++ai)
#pragma unroll
            for (int m = 0; m < 4; ++m) { const int row = row0 + ai * 128 + m * 16;
#pragma unroll
                for (int bj = 0; bj < 2; ++bj) { const size_t o = (size_t)row * 1024 + u.pn * 256 + 128 * bj + 32 * wc + 8 * fq;
                    *(f32x4*)(out + o) = *(const f32x4*)(out + o) + acc[ai][bj][m][0]; *(f32x4*)(out + o + 4) = *(const f32x4*)(out + o + 4) + acc[ai][bj][m][1]; } }
    }
};

__device__ __forceinline__ float wave_sum(float v) {
#pragma unroll
    for (int o = 1; o < 64; o <<= 1) v += __shfl_xor(v, o);
    return v;
}
__device__ __forceinline__ float wave_max(float v) {
#pragma unroll
    for (int o = 1; o < 64; o <<= 1) v = fmaxf(v, __shfl_xor(v, o));
    return v;
}
__device__ __forceinline__ void transpose_item(const float* __restrict__ W, int N, int K, const float* __restrict__ g, bf16_t* WT, int k0, int s0, int dA, int dB, LAS float* scr, int lane) {
    const int lr = lane >> 4, lc = (lane & 15) * 4;
    f32x4 v[16];
#pragma unroll
    for (int i = 0; i < 16; ++i) v[i] = *(const f32x4*)(W + (size_t)(k0 + 4 * i + lr) * N + s0 + lc);
#pragma unroll
    for (int i = 0; i < 16; ++i) { const int kk = 4 * i + lr; f32x4 t = v[i]; if (g) t = t * g[k0 + kk];
        LAS float* d = scr + kk * 65 + lc; d[0] = t[0]; d[1] = t[1]; d[2] = t[2]; d[3] = t[3]; }
    asm volatile("s_waitcnt lgkmcnt(0)" ::: "memory");
    const int c = lane & 7;
#pragma unroll
    for (int j = 0; j < 8; ++j) { const int n = (lane >> 3) + 8 * j; const LAS float* s = scr + (8 * c) * 65 + n;
        u32x4 o; o.x = cvt_pk_bf16(s[0 * 65], s[1 * 65]); o.y = cvt_pk_bf16(s[2 * 65], s[3 * 65]); o.z = cvt_pk_bf16(s[4 * 65], s[5 * 65]); o.w = cvt_pk_bf16(s[6 * 65], s[7 * 65]);
        const int drow = n < 32 ? dA + n : dB + (n - 32);
        *(u32x4*)(WT + (size_t)drow * K + k0 + 8 * c) = o; }
    asm volatile("s_waitcnt lgkmcnt(0)" ::: "memory");
}
template <int NR> __device__ __forceinline__ void rows_to_bf16(const float* x, bf16_t* o, int m0, int stride, int lane) {
    f32x4 v[NR][4];
#pragma unroll
    for (int r = 0; r < NR; ++r) { const f32x4* xr = (const f32x4*)(x + (size_t)(m0 + r * stride) * 1024) + lane;
#pragma unroll
        for (int j = 0; j < 4; ++j) v[r][j] = xr[64 * j]; }
#pragma unroll
    for (int r = 0; r < NR; ++r) { float s = 0.f;
#pragma unroll
        for (int j = 0; j < 4; ++j) s += (v[r][j].x * v[r][j].x + v[r][j].y * v[r][j].y) + (v[r][j].z * v[r][j].z + v[r][j].w * v[r][j].w);
        s = wave_sum(s);
        const float rs = rsqrtf(s * (1.0f / 1024.0f) + EPS);
        u32x2* o8 = (u32x2*)(o + (size_t)(m0 + r * stride) * 1024) + lane;
#pragma unroll
        for (int j = 0; j < 4; ++j) { const f32x4 t = v[r][j] * rs; o8[64 * j] = (u32x2){cvt_pk_bf16(t.x, t.y), cvt_pk_bf16(t.z, t.w)}; } }
}
__device__ __forceinline__ void phase_prep(const Params& P, LAS unsigned char* lds) {
    const int tid = threadIdx.x, lane = tid & 63, wave = tid >> 6;
    unsigned char* ws = P.ws;
    { float* kb = (float*)(ws + WS_KBAR); for (int i = blockIdx.x * 512 + tid; i < 16 * 8 * 16 * 64; i += gridDim.x * 512) kb[i] = 0.f; }
    LAS float* scr = (LAS float*)(lds + wave * 17408);
    constexpr int I_IN = 16 * (INC / 64), I_KV = 16 * 16, I_BR = 8 * 16, I_O = 16 * 16, I_UP = 16 * (2 * DFF / 64), I_DN = (DFF / 64) * 16;
    constexpr int NIT = I_IN + I_KV + 3 * I_BR + I_O + I_UP + I_DN;
    const int gw2 = blockIdx.x * 4 + (wave & 3), NGW2 = gridDim.x * 4;
    if (wave >= 4) {
    for (int it = gw2; it < NIT; it += NGW2) {
        int r = it;
        if (r < I_IN) { const int nb = r % (INC / 64), kb = r / (INC / 64), s0 = nb * 64, pn = s0 >> 8, wcs = (s0 & 255) >> 6;
            transpose_item(P.w_in, INC, 1024, P.g_mix, (bf16_t*)(ws + WS_W1T), kb * 64, s0, pn * 256 + 32 * wcs, pn * 256 + 128 + 32 * wcs, scr, lane); continue; } r -= I_IN;
        if (r < I_KV) { const int d = (r % 16) * 64; transpose_item(P.w_mem_kv, 1024, 1024, P.g_mem, (bf16_t*)(ws + WS_WKVT), (r / 16) * 64, d, d, d + 32, scr, lane); continue; } r -= I_KV;
        if (r < 3 * I_BR) { const int wsel = r / I_BR, q = r % I_BR, d = (q % 16) * 64; const float* W = wsel == 0 ? P.w_br_conv : (wsel == 1 ? P.w_br_moba : P.w_br_mem);
            transpose_item(W, 1024, 512, nullptr, (bf16_t*)(ws + WS_WBRT) + (size_t)wsel * 1024 * 512, (q / 16) * 64, d, d, d + 32, scr, lane); continue; } r -= 3 * I_BR;
        if (r < I_O) { const int d = (r % 16) * 64; transpose_item(P.w_o, 1024, 1024, nullptr, (bf16_t*)(ws + WS_WOT), (r / 16) * 64, d, d, d + 32, scr, lane); continue; } r -= I_O;
        if (r < I_UP) { const int nb = r % (2 * DFF / 64), kb = r / (2 * DFF / 64), d0 = nb * 64, p0 = d0 & 255, pn = d0 >> 8; const int sc = p0 < 128 ? pn * 128 + p0 : DFF + pn * 128 + (p0 - 128);
            transpose_item(P.w_up, 2 * DFF, 1024, P.g_ffn, (bf16_t*)(ws + WS_WUPT), kb * 64, sc, d0, d0 + 32, scr, lane); continue; } r -= I_UP;
        { const int d = (r % 16) * 64; transpose_item(P.w_down, 1024, DFF, nullptr, (bf16_t*)(ws + WS_WDNT), (r / 16) * 64, d, d, d + 32, scr, lane); }
    }
    for (int m = gw2; m < MEMT; m += NGW2) rows_to_bf16<1>(P.mem, (bf16_t*)(ws + WS_MEMB), m, NGW2, lane);
    } else {
    bf16_t* xb = (bf16_t*)P.out;
    if ((T_TOK % (4 * NGW2)) == 0) { for (int m = gw2; m < T_TOK; m += 4 * NGW2) rows_to_bf16<4>(P.x, xb, m, NGW2, lane); }
    else { for (int m = gw2; m < T_TOK; m += NGW2) rows_to_bf16<1>(P.x, xb, m, NGW2, lane); }
    }
}

__device__ __forceinline__ int crow(int r, int hi) { return (r & 3) + 8 * (r >> 2) + 4 * hi; }
#define MFMA32(a, b, c) __builtin_amdgcn_mfma_f32_32x32x16_bf16((a), (b), (c), 0, 0, 0)

constexpr int MOBA_KS = 144, MOBA_VS = 520, MOBA_VOFF = 256 * MOBA_KS;
__device__ __forceinline__ unsigned moba_select(const float* kbar, int b, int h, int n, int ql, int hi, const bf16x8 (&qf)[4]) {
    f32x16 g;
#pragma unroll
    for (int i = 0; i < 16; ++i) g[i] = 0.f;
    const float* kb = kbar + ((size_t)(b * 8 + h) * 16 + (ql & 15)) * 64 + 8 * hi;
#pragma unroll
    for (int ks = 0; ks < 4; ++ks) { f32x4 x0 = *(const f32x4*)(kb + 16 * ks), x1 = *(const f32x4*)(kb + 16 * ks + 4);
        if (ql >= 16) { x0 = (f32x4){0.f, 0.f, 0.f, 0.f}; x1 = x0; }
        const u32x4 pk = pack8(x0 * (1.0f / 256.0f), x1 * (1.0f / 256.0f)); g = MFMA32(__builtin_bit_cast(bf16x8, pk), qf[ks], g); }
    float gv[16];
#pragma unroll
    for (int i = 0; i < 8; ++i) { const float own = g[i], oth = __shfl_xor(own, 32); const int bb = (i & 3) + 8 * (i >> 2); gv[bb] = hi ? oth : own; gv[bb + 4] = hi ? own : oth; }
#pragma unroll
    for (int j = 0; j < 16; ++j) if (j >= n) gv[j] = -INFINITY;
    unsigned selmask = 0;
#pragma unroll
    for (int t = 0; t < 3; ++t) { float best = -INFINITY; int bi = -1;
#pragma unroll
        for (int j = 0; j < 16; ++j) if (gv[j] > best) { best = gv[j]; bi = j; }
        if (bi >= 0) selmask |= 1u << bi;
#pragma unroll
        for (int j = 0; j < 16; ++j) if (j == bi) gv[j] = -INFINITY; }
    return selmask;
}
__device__ __forceinline__ void moba_unit(const Params& P, LAS unsigned char* lds, int b, int h, int n, bool first, int nnext, u32x4 (&kr)[4], u32x4 (&vr)[4]) {
    int tid = threadIdx.x; asm volatile("" : "+v"(tid));
    const int lane = tid & 63, w = __builtin_amdgcn_readfirstlane(tid >> 6), ql = lane & 31, hi = lane >> 5, qg = w & 3, kh = w >> 2;
    const bf16_t* qk = (const bf16_t*)(P.ws + WS_QK); const bf16_t* vT = (const bf16_t*)(P.ws + WS_VT); const float* kbar = (const float*)(P.ws + WS_KBAR);
    bf16_t* ymoba = (bf16_t*)P.out + (size_t)T_TOK * 512;
    LAS unsigned char* Ks = lds; LAS unsigned char* Vt = lds + MOBA_VOFF;
    const size_t tq0 = (size_t)b * SEQ + 256 * n + 64 * qg + ql;
    bf16x8 qf[2][4];
#pragma unroll
    for (int c = 0; c < 2; ++c)
#pragma unroll
        for (int ks = 0; ks < 4; ++ks) qf[c][ks] = *(const bf16x8*)(qk + (tq0 + 32 * c) * 1024 + h * 64 + 16 * ks + 8 * hi);
    unsigned selm0 = 0, selm1 = 0;
    if (n > 0) { selm0 = moba_select(kbar, b, h, n, ql, hi, qf[0]); selm1 = moba_select(kbar, b, h, n, ql, hi, qf[1]); }
    f32x16 o[2][2];
#pragma unroll
    for (int c = 0; c < 2; ++c)
#pragma unroll
        for (int d = 0; d < 2; ++d)
#pragma unroll
            for (int i = 0; i < 16; ++i) o[c][d][i] = 0.f;
    float ls[2] = {0.f, 0.f};
    const bf16_t* kbase = qk + ((size_t)b * SEQ) * 1024 + 512 + h * 64; const bf16_t* vbase = vT + ((size_t)(b * 8 + h) * 64) * 4096;
#define MOBA_LOAD(j) do { int t2 = tid; asm volatile("" : "+v"(t2)); _Pragma("unroll") for (int i = 0; i < 4; ++i) { const int p = t2 + 512 * i; \
        kr[i] = *(const u32x4*)(kbase + (size_t)(256 * (j) + (p >> 3)) * 1024 + (p & 7) * 8); \
        vr[i] = *(const u32x4*)(vbase + (size_t)(p >> 5) * 4096 + 256 * (j) + (p & 31) * 8); } } while (0)
    if (first) MOBA_LOAD(n);
    f32x16 zero16;
#pragma unroll
    for (int i = 0; i < 16; ++i) zero16[i] = 0.f;
    for (int it = 0; it <= n; ++it) {
        const int j = (it == 0) ? n : it - 1;
        __syncthreads();
        int t3 = tid; asm volatile("" : "+v"(t3));
#pragma unroll
        for (int i = 0; i < 4; ++i) { const int p = t3 + 512 * i;
            *(LAS u32x4*)(Ks + (p >> 3) * MOBA_KS + (p & 7) * 16) = kr[i];
            LAS unsigned char* vp = Vt + (p >> 5) * MOBA_VS + (p & 31) * 16;
            *(LAS u32x2*)vp = (u32x2){vr[i].x, vr[i].y}; *(LAS u32x2*)(vp + 8) = (u32x2){vr[i].z, vr[i].w}; }
        __syncthreads();
        if (it < n) MOBA_LOAD(it); else if (nnext >= 0) MOBA_LOAD(nnext);
        const bool own = (j == n);
        const bool sel0 = own || ((selm0 >> j) & 1u), sel1 = own || ((selm1 >> j) & 1u);
        if (__ballot(sel0 || sel1) == 0ull) continue;
        const unsigned selw0 = sel0 ? 0xffffffffu : 0u, selw1 = sel1 ? 0xffffffffu : 0u;
        float lb0 = 0.f, lb1 = 0.f;
        const int ntl = own ? (2 * qg + 2 - 4 * kh) : 4;
        for (int t = 0; t < ntl && t < 4; ++t) {
            const int kt = 4 * kh + t;
            const LAS unsigned char* kp = Ks + (32 * kt + ql) * MOBA_KS + 16 * hi;
            bf16x8 kf[4];
#pragma unroll
            for (int ks = 0; ks < 4; ++ks) kf[ks] = *(const LAS bf16x8*)(kp + 32 * ks);
            __builtin_amdgcn_sched_barrier(0);
            f32x16 s0 = MFMA32(kf[0], qf[0][0], zero16);
#pragma unroll
            for (int ks = 1; ks < 4; ++ks) s0 = MFMA32(kf[ks], qf[0][ks], s0);
            f32x16 s1 = MFMA32(kf[0], qf[1][0], zero16);
#pragma unroll
            for (int ks = 1; ks < 4; ++ks) s1 = MFMA32(kf[ks], qf[1][ks], s1);
            __builtin_amdgcn_sched_barrier(0);
            const LAS unsigned char* vp = Vt + ql * MOBA_VS + (32 * kt + 4 * hi) * 2;
            u32x2 vf[2][2][2];
#pragma unroll
            for (int d = 0; d < 2; ++d)
#pragma unroll
                for (int k2 = 0; k2 < 2; ++k2) { vf[d][k2][0] = *(const LAS u32x2*)(vp + 32 * d * MOBA_VS + 32 * k2); vf[d][k2][1] = *(const LAS u32x2*)(vp + 32 * d * MOBA_VS + 32 * k2 + 16); }
            __builtin_amdgcn_sched_barrier(0);
            if (own) {
                if (kt == 2 * qg) {
#pragma unroll
                    for (int i = 0; i < 16; ++i) if (crow(i, hi) > ql) s0[i] = -1e30f;
                }
                if (kt == 2 * qg + 1) {
#pragma unroll
                    for (int i = 0; i < 16; ++i) { s0[i] = -1e30f; if (crow(i, hi) > ql) s1[i] = -1e30f; }
                }
            }
            u32x4 pa[2];
#pragma unroll
            for (int i = 0; i < 8; ++i) { const float e0 = __builtin_amdgcn_exp2f(s0[2 * i]), e1 = __builtin_amdgcn_exp2f(s0[2 * i + 1]); lb0 += e0; lb0 += e1; pa[i >> 2][i & 3] = cvt_pk_bf16_t(e0, e1) & selw0; }
            __builtin_amdgcn_sched_barrier(0);
            bf16x8 av[2][2];
#pragma unroll
            for (int k2 = 0; k2 < 2; ++k2)
#pragma unroll
                for (int d = 0; d < 2; ++d) { const u32x4 a = (u32x4){vf[d][k2][0].x, vf[d][k2][0].y, vf[d][k2][1].x, vf[d][k2][1].y}; av[d][k2] = __builtin_bit_cast(bf16x8, a); }
#pragma unroll
            for (int k2 = 0; k2 < 2; ++k2)
#pragma unroll
                for (int d = 0; d < 2; ++d) o[0][d] = MFMA32(av[d][k2], __builtin_bit_cast(bf16x8, pa[k2]), o[0][d]);
            __builtin_amdgcn_sched_barrier(0);
            u32x4 pb[2];
#pragma unroll
            for (int i = 0; i < 8; ++i) { const float e0 = __builtin_amdgcn_exp2f(s1[2 * i]), e1 = __builtin_amdgcn_exp2f(s1[2 * i + 1]); lb1 += e0; lb1 += e1; pb[i >> 2][i & 3] = cvt_pk_bf16_t(e0, e1) & selw1; }
            __builtin_amdgcn_sched_barrier(0);
#pragma unroll
            for (int k2 = 0; k2 < 2; ++k2)
#pragma unroll
                for (int d = 0; d < 2; ++d) o[1][d] = MFMA32(av[d][k2], __builtin_bit_cast(bf16x8, pb[k2]), o[1][d]);
            __builtin_amdgcn_sched_barrier(0);
        }
        if (sel0) ls[0] += lb0;
        if (sel1) ls[1] += lb1;
    }
#undef MOBA_LOAD
    ls[0] += __shfl_xor(ls[0], 32); ls[1] += __shfl_xor(ls[1], 32);
    __syncthreads();
    LAS float* xo = (LAS float*)lds; LAS float* xl = (LAS float*)(lds + 65536);
    if (kh == 1) {
#pragma unroll
        for (int c = 0; c < 2; ++c) { xl[(qg * 2 + c) * 64 + lane] = ls[c];
#pragma unroll
            for (int d = 0; d < 2; ++d)
#pragma unroll
                for (int i = 0; i < 16; ++i) xo[(((qg * 2 + c) * 2 + d) * 16 + i) * 64 + lane] = o[c][d][i]; }
    }
    __syncthreads();
    if (kh == 0) {
#pragma unroll
        for (int c = 0; c < 2; ++c) { const float inv = 1.0f / (ls[c] + xl[(qg * 2 + c) * 64 + lane]);
            bf16_t* yp = ymoba + (tq0 + 32 * c) * 512 + h * 64 + 4 * hi;
#pragma unroll
            for (int d = 0; d < 2; ++d) {
                float v[16];
#pragma unroll
                for (int i = 0; i < 16; ++i) v[i] = (o[c][d][i] + xo[(((qg * 2 + c) * 2 + d) * 16 + i) * 64 + lane]) * inv;
#pragma unroll
                for (int g4 = 0; g4 < 4; ++g4) *(u32x2*)(yp + 32 * d + 8 * g4) = (u32x2){cvt_pk_bf16(v[4 * g4], v[4 * g4 + 1]), cvt_pk_bf16(v[4 * g4 + 2], v[4 * g4 + 3])}; }
        }
    }
}

constexpr int MEM_KS = 272, MEM_VS = 520, MEM_VOFF = 256 * MEM_KS;
__device__ __forceinline__ void mem_unit(const Params& P, LAS unsigned char* lds, int b, int hm, int qt0) {
    const int tid = threadIdx.x, lane = tid & 63, w = tid >> 6, ql = lane & 31, hi = lane >> 5;
    const bf16_t* qm = (const bf16_t*)(P.ws + WS_QM); const bf16_t* memk = (const bf16_t*)(P.ws + WS_MEMK); const bf16_t* memvT = (const bf16_t*)(P.ws + WS_MEMVT);
    bf16_t* ymem = (bf16_t*)P.out + (size_t)T_TOK * 1024;
    LAS unsigned char* Km = lds; LAS unsigned char* Vm = lds + MEM_VOFF;
    __syncthreads();
#pragma unroll
    for (int i = 0; i < 8; ++i) { const int p = tid + 512 * i, row = p >> 4, c = p & 15;
        f32x4 f0, f1; unpack8(*(const u32x4*)(memk + ((size_t)b * 256 + row) * 512 + hm * 128 + c * 8), f0, f1);
        const f32x4 q0 = f0 * f0, q1 = f1 * f1; float ss = ((q0[0] + q0[1]) + (q0[2] + q0[3])) + ((q1[0] + q1[1]) + (q1[2] + q1[3]));
        ss += __shfl_xor(ss, 1); ss += __shfl_xor(ss, 2); ss += __shfl_xor(ss, 4); ss += __shfl_xor(ss, 8);
        const float rk = rsqrtf(ss * (1.0f / 128.0f) + EPS);
        const f32x4 g0 = *(const f32x4*)(P.memk_g + c * 8), g1 = *(const f32x4*)(P.memk_g + c * 8 + 4);
        *(LAS u32x4*)(Km + row * MEM_KS + c * 16) = pack8(f0 * rk * g0, f1 * rk * g1); }
#pragma unroll
    for (int i = 0; i < 8; ++i) { const int p = tid + 512 * i, d = p >> 5, c = p & 31;
        const u32x4 v = *(const u32x4*)(memvT + ((size_t)(b * 4 + hm) * 128 + d) * 256 + c * 8);
        LAS unsigned char* vp = Vm + d * MEM_VS + c * 16; *(LAS u32x2*)vp = (u32x2){v.x, v.y}; *(LAS u32x2*)(vp + 8) = (u32x2){v.z, v.w}; }
    __syncthreads();
    for (int qt = qt0; qt < qt0 + 4; ++qt) {
        const size_t tq = (size_t)b * SEQ + 256 * qt + 32 * w + ql;
        bf16x8 qf[8];
        { f32x4 f[8][2]; float ss = 0.f;
#pragma unroll
            for (int ks = 0; ks < 8; ++ks) { unpack8(*(const u32x4*)(qm + tq * 512 + hm * 128 + 16 * ks + 8 * hi), f[ks][0], f[ks][1]);
                const f32x4 q0 = f[ks][0] * f[ks][0], q1 = f[ks][1] * f[ks][1]; ss += ((q0[0] + q0[1]) + (q0[2] + q0[3])) + ((q1[0] + q1[1]) + (q1[2] + q1[3])); }
            ss += __shfl_xor(ss, 32);
            const float rq = rsqrtf(ss * (1.0f / 128.0f) + EPS) * C2_MEM;
#pragma unroll
            for (int ks = 0; ks < 8; ++ks) { const f32x4 g0 = *(const f32x4*)(P.memq_g + 16 * ks + 8 * hi), g1 = *(const f32x4*)(P.memq_g + 16 * ks + 8 * hi + 4);
                const u32x4 pk = pack8(f[ks][0] * rq * g0, f[ks][1] * rq * g1); qf[ks] = __builtin_bit_cast(bf16x8, pk); } }
        f32x16 o[4];
#pragma unroll
        for (int d = 0; d < 4; ++d)
#pragma unroll
            for (int i = 0; i < 16; ++i) o[d][i] = 0.f;
        float lsum = 0.f;
        for (int kt = 0; kt < 8; ++kt) {
            f32x16 s;
#pragma unroll
            for (int i = 0; i < 16; ++i) s[i] = 0.f;
            const LAS unsigned char* kp = Km + (32 * kt + ql) * MEM_KS + 16 * hi;
#pragma unroll
            for (int ks = 0; ks < 8; ++ks) s = MFMA32(*(const LAS bf16x8*)(kp + 32 * ks), qf[ks], s);
            float pe[16];
#pragma unroll
            for (int i = 0; i < 16; ++i) { pe[i] = __builtin_amdgcn_exp2f(s[i]); lsum += pe[i]; }
            u32x4 pa0, pa1;
            pa0.x = cvt_pk_bf16_t(pe[0], pe[1]); pa0.y = cvt_pk_bf16_t(pe[2], pe[3]); pa0.z = cvt_pk_bf16_t(pe[4], pe[5]); pa0.w = cvt_pk_bf16_t(pe[6], pe[7]);
            pa1.x = cvt_pk_bf16_t(pe[8], pe[9]); pa1.y = cvt_pk_bf16_t(pe[10], pe[11]); pa1.z = cvt_pk_bf16_t(pe[12], pe[13]); pa1.w = cvt_pk_bf16_t(pe[14], pe[15]);
            const LAS unsigned char* vp = Vm + ql * MEM_VS + (32 * kt + 4 * hi) * 2;
#pragma unroll
            for (int kf = 0; kf < 2; ++kf) { const bf16x8 pb = __builtin_bit_cast(bf16x8, kf ? pa1 : pa0);
#pragma unroll
                for (int d = 0; d < 4; ++d) { const u32x2 lo = *(const LAS u32x2*)(vp + 32 * d * MEM_VS + 32 * kf), h8 = *(const LAS u32x2*)(vp + 32 * d * MEM_VS + 32 * kf + 16);
                    const u32x4 a = (u32x4){lo.x, lo.y, h8.x, h8.y}; o[d] = MFMA32(__builtin_bit_cast(bf16x8, a), pb, o[d]); } }
        }
        lsum += __shfl_xor(lsum, 32);
        const float inv = 1.0f / lsum;
        bf16_t* yp = ymem + tq * 512 + hm * 128 + 4 * hi;
#pragma unroll
        for (int d = 0; d < 4; ++d)
#pragma unroll
            for (int g4 = 0; g4 < 4; ++g4)
                *(u32x2*)(yp + 32 * d + 8 * g4) = (u32x2){cvt_pk_bf16(o[d][4 * g4] * inv, o[d][4 * g4 + 1] * inv), cvt_pk_bf16(o[d][4 * g4 + 2] * inv, o[d][4 * g4 + 3] * inv)};
    }
}

__device__ __forceinline__ void conv_slice(const Params& P, int slice) {
    const bf16_t* cv = (const bf16_t*)(P.ws + WS_CONV); bf16_t* yc = (bf16_t*)P.out;
    const int tid = threadIdx.x;
    for (int i = 0; i < 4; ++i) { const int item = tid + 512 * i, cgp = item & 63, rg = item >> 6; const int t0 = slice * 256 + 8 * rg, c = 8 * cgp;
        f32x4 w0[2], w1[2], w2[2], bi[2];
#pragma unroll
        for (int k = 0; k < 2; ++k) { w0[k] = *(const f32x4*)(P.conv_w + c + 4 * k); w1[k] = *(const f32x4*)(P.conv_w + 512 + c + 4 * k); w2[k] = *(const f32x4*)(P.conv_w + 1024 + c + 4 * k); bi[k] = *(const f32x4*)(P.conv_b + c + 4 * k); }
        const bool first = (t0 & (SEQ - 1)) == 0;
        u32x4 rc[10], rx[10], rb[8];
#pragma unroll
        for (int r = 0; r < 10; ++r) { const size_t t = (size_t)(t0 - 2 + r);
            if (r >= 2 || !first) { rc[r] = *(const u32x4*)(cv + t * 1536 + 512 + c); rx[r] = *(const u32x4*)(cv + t * 1536 + 1024 + c); } else { rc[r] = (u32x4){0u, 0u, 0u, 0u}; rx[r] = rc[r]; }
            if (r >= 2) rb[r - 2] = *(const u32x4*)(cv + t * 1536 + c); }
        f32x4 m2[2], m1[2];
        { f32x4 a0, a1, b0, b1; unpack8(rc[0], a0, a1); unpack8(rx[0], b0, b1); m2[0] = a0 * b0; m2[1] = a1 * b1; unpack8(rc[1], a0, a1); unpack8(rx[1], b0, b1); m1[0] = a0 * b0; m1[1] = a1 * b1; }
#pragma unroll
        for (int r = 0; r < 8; ++r) { const size_t t = (size_t)(t0 + r); f32x4 a0, a1, b0, b1, g0, g1;
            unpack8(rc[r + 2], a0, a1); unpack8(rx[r + 2], b0, b1); unpack8(rb[r], g0, g1);
            const f32x4 m00 = a0 * b0, m01 = a1 * b1;
            const f32x4 y0 = g0 * (w0[0] * m2[0] + w1[0] * m1[0] + w2[0] * m00 + bi[0]), y1 = g1 * (w0[1] * m2[1] + w1[1] * m1[1] + w2[1] * m01 + bi[1]);
            *(u32x4*)(yc + t * 512 + c) = pack8(y0, y1);
            m2[0] = m1[0]; m2[1] = m1[1]; m1[0] = m00; m1[1] = m01; }
    }
}

__device__ __forceinline__ void phase_mixers(const Params& P, LAS unsigned char* lds) {
    if (P.sub & 1) for (int c = blockIdx.x; c < 256; c += gridDim.x) {
        const int bh = c >> 1, odd = c & 1;
        u32x4 kr[4], vr[4];
        for (int i = 0; i < 8; ++i) { const int e = 2 * (i >> 1); const int n = (i & 1) ? (15 - e - odd) : (e + odd);
            const int i2 = i + 1, e2 = 2 * (i2 >> 1); const int nn = i2 < 8 ? ((i2 & 1) ? (15 - e2 - odd) : (e2 + odd)) : -1;
            moba_unit(P, lds, bh >> 3, bh & 7, n, i == 0, nn, kr, vr); }
    }
    if (P.sub & 2) for (int c = blockIdx.x; c < 256; c += gridDim.x) mem_unit(P, lds, c >> 4, (c >> 2) & 3, (c & 3) * 4);
    if (P.sub & 4) for (int c = blockIdx.x; c < 256; c += gridDim.x) conv_slice(P, c);
}

__device__ __forceinline__ void phase_ffn_fix(const Params& P) {
    const float* halo = (const float*)(P.ws + WS_AR); bf16_t* u = (bf16_t*)(P.ws + WS_BU);
    constexpr int CG = DFF / 8;
    const int total = 1024 * 2 * CG;
    for (int idx = blockIdx.x * 512 + threadIdx.x; idx < total; idx += gridDim.x * 512) {
        const int cgp = idx % CG, rr = idx / CG, r = rr & 1, G = rr >> 1, c = cgp * 8;
        const bool seq0 = (G & 63) == 0;
        const float* hg = halo + (size_t)G * 6 * DFF + c; const float* hp = halo + (size_t)(G - 1) * 6 * DFF + c;
        f32x4 z[2];
#pragma unroll
        for (int k = 0; k < 2; ++k) {
            const f32x4 w0 = *(const f32x4*)(P.ffn_conv_w + c + 4 * k), w1 = *(const f32x4*)(P.ffn_conv_w + DFF + c + 4 * k), w2 = *(const f32x4*)(P.ffn_conv_w + 2 * DFF + c + 4 * k), bi = *(const f32x4*)(P.ffn_conv_b + c + 4 * k);
            const f32x4 zero = (f32x4){0.f, 0.f, 0.f, 0.f};
            const f32x4 a = *(const f32x4*)(hg + (size_t)(2 + r) * DFF + 4 * k), b = *(const f32x4*)(hg + (size_t)(4 + r) * DFF + 4 * k);
            f32x4 p1, p2;
            if (r == 0) { p1 = seq0 ? zero : *(const f32x4*)(hp + (size_t)1 * DFF + 4 * k); p2 = seq0 ? zero : *(const f32x4*)(hp + 4 * k); }
            else { p1 = *(const f32x4*)(hg + (size_t)2 * DFF + 4 * k); p2 = seq0 ? zero : *(const f32x4*)(hp + (size_t)1 * DFF + 4 * k); }
            f32x4 t = w0 * p2 + w1 * p1 + w2 * a + bi;
#pragma unroll
            for (int e = 0; e < 4; ++e) t[e] = t[e] * fast_sigmoid(t[e]) * b[e];
            z[k] = t; }
        *(u32x4*)(u + (size_t)(G * 64 + r) * DFF + c) = pack8(z[0], z[1]);
    }
}

#define XB_TMO      128
#define XB_XCNT(j)  (256  + 64 * (j))
#define XB_XSUB(j)  (1280 + 64 * (j))
#define XB_XGEN(j)  (2304 + 64 * (j))
#define XB_TOP      3328
#define XB_TOPGEN   3392
#define XCD_BAR_WORDS 3456
#define XB_SPIN_CAP (1u << 18)

__device__ __forceinline__ unsigned xb_ld(unsigned* p)              { return __hip_atomic_load(p, __ATOMIC_RELAXED, __HIP_MEMORY_SCOPE_AGENT); }
__device__ __forceinline__ unsigned xb_add(unsigned* p, unsigned v) { return __hip_atomic_fetch_add(p, v, __ATOMIC_RELAXED, __HIP_MEMORY_SCOPE_AGENT); }
__device__ __forceinline__ unsigned xb_xcc_id() { return (unsigned)__builtin_amdgcn_s_getreg((3 << 11) | 20) & 0xFu; }
#define XB_SPIN(cond, bar) do { unsigned _sp = 0; while (cond) { __builtin_amdgcn_s_sleep(1); \
    if ((++_sp & 255u) == 0u) { if (xb_ld(&(bar)[XB_TMO])) break; if (_sp > XB_SPIN_CAP) { atomicAdd(&(bar)[XB_TMO], 1u); break; } } } } while (0)

struct XcdBarrier {
    unsigned* bar; unsigned x;
    volatile LAS unsigned* st;
};

__device__ __forceinline__ XcdBarrier xcd_barrier_post(unsigned* bar, volatile LAS unsigned* st) {
    XcdBarrier b; b.bar = bar; b.x = xb_xcc_id(); b.st = st;
    if (threadIdx.x == 0) (void)xb_add(&bar[XB_XCNT(b.x)], 1u);
    return b;
}
__device__ __forceinline__ void xcd_barrier_complete(unsigned* bar, unsigned x, unsigned& nloc, unsigned& nx) {
    const unsigned G = gridDim.x;
    unsigned sum, cnt, mine, sp = 0u;
    for (;;) {
        sum = 0u; cnt = 0u; mine = 0u;
#pragma unroll
        for (unsigned j = 0; j < 16; ++j) { const unsigned c = xb_ld(&bar[XB_XCNT(j)]); sum += c; cnt += (c > 0u) ? 1u : 0u; mine = (j == x) ? c : mine; }
        if (sum == G) break;
        __builtin_amdgcn_s_sleep(1);
        if ((++sp & 255u) == 0u) { if (xb_ld(&bar[XB_TMO])) break; if (sp > XB_SPIN_CAP) { atomicAdd(&bar[XB_TMO], 1u); break; } }
    }
    nloc = mine > 0u ? mine : 1u; nx = cnt > 0u ? cnt : 1u;
}

__device__ __forceinline__ void xcd_barrier(const XcdBarrier& b) {
    asm volatile("s_waitcnt vmcnt(0)" ::: "memory");
    __syncthreads();
    if (threadIdx.x == 0) {
        unsigned* bar = b.bar;
        __builtin_amdgcn_s_waitcnt(0);
        unsigned nloc = b.st[0], nx = b.st[1];
        if (nloc == 0u) { xcd_barrier_complete(bar, b.x, nloc, nx); b.st[0] = nloc; b.st[1] = nx; }
        const unsigned old = xb_add(&bar[XB_XSUB(b.x)], 1u);
        const unsigned gen = old / nloc;
        if (old + 1u == (gen + 1u) * nloc) {
            __builtin_amdgcn_fence(__ATOMIC_RELEASE, "agent");
            asm volatile("s_waitcnt vmcnt(0)" ::: "memory");
            const unsigned og = xb_add(&bar[XB_TOP], 1u);
            const unsigned tg = og / nx;
            if (og + 1u == (tg + 1u) * nx) xb_add(&bar[XB_TOPGEN], 1u);
            else XB_SPIN(xb_ld(&bar[XB_TOPGEN]) == tg, bar);
            __builtin_amdgcn_fence(__ATOMIC_ACQUIRE, "agent");
            xb_add(&bar[XB_XGEN(b.x)], 1u);
            asm volatile("s_waitcnt vmcnt(0)" ::: "memory");
        } else {
            XB_SPIN(xb_ld(&bar[XB_XGEN(b.x)]) == gen, bar);
            __builtin_amdgcn_fence(__ATOMIC_ACQUIRE, "agent");
            asm volatile("s_waitcnt vmcnt(0)" ::: "memory");
        }
    }
    __syncthreads();
}

constexpr int NPHASE = 8;
__global__ void __launch_bounds__(512, 2) mk_fwd(Params P) {
    extern __shared__ __attribute__((aligned(16))) unsigned char lds_raw[];
    LAS unsigned char* lds = (LAS unsigned char*)lds_raw;
    cg::grid_group grid = cg::this_grid();
    unsigned char* ws = P.ws;
    const int G = gridDim.x, bx = blockIdx.x;
    const int lo = P.ph_lo, hi = P.ph_hi;
    volatile LAS unsigned* bst = (volatile LAS unsigned*)(lds + LDS_BARST);
    if (threadIdx.x < 2) bst[threadIdx.x] = 0u;
    __syncthreads();
    (void)xcd_barrier_post((unsigned*)(ws + WS_BAR) + P.pad * 4096, bst);
#if 1
    if (P.ph_lo < 0) grid.sync();
#endif
#ifndef SUBM
#define SUBM 31
#endif
#ifndef PH_MASK
#define PH_MASK 0xff
#endif
#define IN(k) (((PH_MASK >> (k)) & 1) && lo <= (k) && (k) < hi)
#define SEAM(k) do { if (IN(k) && IN((k) + 1)) { { XcdBarrier xb_; xb_.bar = (unsigned*)(ws + WS_BAR) + P.pad * 4096; xb_.x = xb_xcc_id(); xb_.st = (volatile LAS unsigned*)(lds + LDS_BARST); xcd_barrier(xb_); } } } while (0)
    if (IN(0)) { phase_prep(P, lds); __syncthreads(); }
    SEAM(0);
#ifdef EXTRA_SYNCS
    for (int i = 0; i < EXTRA_SYNCS; ++i) SEAM(0);
#endif
    if (IN(1)) {
        { pg8::GemmStd g{(const bf16_t*)P.out, (const bf16_t*)(ws + WS_W1T), 1024};
#define EPI_IN_ARGS (bf16_t*)(ws + WS_CONV), (bf16_t*)(ws + WS_QK), (bf16_t*)(ws + WS_VT), (bf16_t*)(ws + WS_QM), (bf16_t*)(ws + WS_GATES), P.b_gate, P.moba_qg, P.moba_kg, (float*)(ws + WS_KBAR)
          if (SUBM & 2) { SubOrder S; S.base.init(T_TOK, 4 * 256, G, bx); S.split = 4; S.off0 = 6; S.off1 = 0; EpiIn<1> E{EPI_IN_ARGS};
            pg8::gemm_phase<EpiIn<1>, SubOrder, pg8::GemmStd, true, true>(lds, g, S, E); }
          if (SUBM & 4) { pg8::GemmStd gv{(const bf16_t*)(ws + WS_W1T) + (size_t)2560 * 1024, (const bf16_t*)P.out, 1024};
            pg8::StaticOrder S; S.init(512, T_TOK, G, bx); EpiVT E{(bf16_t*)(ws + WS_VT)};
            pg8::gemm_phase<EpiVT, pg8::StaticOrder, pg8::GemmStd, true, true>(lds, gv, S, E); }
          if (SUBM & 1) { SubOrder S; S.base.init(T_TOK, 8 * 256, G, bx); S.split = 6; S.off0 = 0; S.off1 = 12; EpiIn<0> E{EPI_IN_ARGS};
            pg8::gemm_phase<EpiIn<0>, SubOrder, pg8::GemmStd, true, true>(lds, g, S, E); }
          if (SUBM & 8) { SubOrder S; S.base.init(T_TOK, 12 * 256, G, bx); S.split = 12; S.off0 = 14; S.off1 = 0; EpiIn<3> E{EPI_IN_ARGS};
            pg8::gemm_phase<EpiIn<3>, SubOrder, pg8::GemmStd, true, true>(lds, g, S, E); }
#undef EPI_IN_ARGS
        }
        if (SUBM & 16) { pg8::GemmStd g{(const bf16_t*)(ws + WS_MEMB), (const bf16_t*)(ws + WS_WKVT), 1024}; pg8::StaticOrder S; S.init(MEMT, 1024, G, bx);
          EpiMemKV E{(bf16_t*)(ws + WS_MEMK), (bf16_t*)(ws + WS_MEMVT)};
          pg8::gemm_phase<EpiMemKV, pg8::StaticOrder, pg8::GemmStd, true, true>(lds, g, S, E); }
    }
    SEAM(1);
    if (IN(2)) { phase_mixers(P, lds); __syncthreads(); }
    SEAM(2);
    if (IN(3)) {
        const bf16_t* y = (const bf16_t*)P.out;
        pg8::GemmSeg3 g{y, y + (size_t)T_TOK * 512, y + (size_t)T_TOK * 1024, (const bf16_t*)(ws + WS_WBRT), 512};
        SegOrder S; S.base.init(T_TOK, 1024, G, bx);
        EpiMerge E{(const bf16_t*)(ws + WS_GATES), (bf16_t*)(ws + WS_MERGED)};
        pg8::gemm_phase<EpiMerge, SegOrder, pg8::GemmSeg3, true, true>(lds, g, S, E);
    }
    SEAM(3);
    if (IN(4)) {
        pg8::GemmStd g{(const bf16_t*)(ws + WS_MERGED), (const bf16_t*)(ws + WS_WOT), 1024}; pg8::StaticOrder S; S.init(T_TOK, 1024, G, bx);
        EpiWo E{P.x, P.out, (bf16_t*)(ws + WS_X1B), (float*)(ws + WS_SSQ)};
        pg8::gemm_phase<EpiWo, pg8::StaticOrder, pg8::GemmStd, true, true>(lds, g, S, E);
    }
    SEAM(4);
    if (IN(5)) {
        pg8::GemmStd g{(const bf16_t*)(ws + WS_X1B), (const bf16_t*)(ws + WS_WUPT), 1024}; pg8::StaticOrder S; S.init(T_TOK, 2 * DFF, G, bx);
        EpiUp E{(const float*)(ws + WS_SSQ), (bf16_t*)(ws + WS_BU), (float*)(ws + WS_AR), P.ffn_conv_w, P.ffn_conv_b};
        pg8::gemm_phase<EpiUp, pg8::StaticOrder, pg8::GemmStd, true, true>(lds, g, S, E);
    }
    SEAM(5);
    if (IN(6)) phase_ffn_fix(P);
    SEAM(6);
    if (IN(7)) {
        pg8::GemmStd g{(const bf16_t*)(ws + WS_BU), (const bf16_t*)(ws + WS_WDNT), DFF}; pg8::StaticOrder S; S.init(T_TOK, 1024, G, bx);
        EpiDown E{P.out};
        pg8::gemm_phase<EpiDown, pg8::StaticOrder, pg8::GemmStd, true, true>(lds, g, S, E);
    }
#undef IN
#undef SEAM
}

#if defined(__HIP_DEVICE_COMPILE__)
#pragma clang attribute pop
#endif
extern "C" void kernel_launch(void* const* d_in, const int* in_sizes, int n_in, void* d_out, int out_size, void* d_ws, size_t ws_size, hipStream_t stream) {
    static int grid = 0;
    if (grid == 0) {
        if (n_in != 22 || in_sizes[0] != T_TOK * DM || out_size != T_TOK * DM || ws_size < WS_NEED) {
            fprintf(stderr, "kernel_launch: unexpected shapes: n_in %d in0 %d out %d ws %zu (need %zu)\n", n_in, n_in > 0 ? in_sizes[0] : -1, out_size, ws_size, (size_t)WS_NEED); grid = -1; return; }
        int dev = 0, cus = 0, per_cu = 0;
        (void)hipGetDevice(&dev); (void)hipDeviceGetAttribute(&cus, hipDeviceAttributeMultiprocessorCount, dev);
        if (hipFuncSetAttribute((const void*)mk_fwd, hipFuncAttributeMaxDynamicSharedMemorySize, LDS_BYTES) != hipSuccess) { fprintf(stderr, "kernel_launch: hipFuncSetAttribute failed\n"); grid = -1; return; }
        if (hipOccupancyMaxActiveBlocksPerMultiprocessor(&per_cu, (const void*)mk_fwd, 512, LDS_BYTES) != hipSuccess || per_cu < 1) { fprintf(stderr, "kernel_launch: occupancy query says %d\n", per_cu); per_cu = 1; }
        (void)hipGetLastError();
        grid = cus * per_cu;
    }
    if (grid < 0) return;
    if (hipMemsetAsync((char*)d_ws + WS_BAR, 0, 4 * 16384, stream) != hipSuccess) { fprintf(stderr, "kernel_launch: memset of the barrier words failed\n"); return; }
    Params p{};
    const float** pp = (const float**)&p;
    for (int i = 0; i < 22; ++i) pp[i] = (const float*)d_in[i];
    p.out = (float*)d_out; p.ws = (unsigned char*)d_ws;
#ifdef MK_RANGES
    { const int rg[][3] = MK_RANGES;
      for (unsigned k = 0; k < sizeof(rg) / sizeof(rg[0]); ++k) { p.ph_lo = rg[k][0]; p.ph_hi = rg[k][1]; p.sub = rg[k][2]; p.pad = (int)k; void* args[] = {&p};
        hipError_t e = hipLaunchCooperativeKernel((const void*)mk_fwd, dim3(grid), dim3(512), args, LDS_BYTES, stream);
        if (e != hipSuccess) { fprintf(stderr, "launch %u failed: %s\n", k, hipGetErrorString(e)); break; } } }
#else
    p.ph_lo = 0; p.ph_hi = NPHASE; p.sub = 7; void* args[] = {&p};
    hipError_t e = hipLaunchCooperativeKernel((const void*)mk_fwd, dim3(grid), dim3(512), args, LDS_BYTES, stream);
    if (e != hipSuccess) fprintf(stderr, "cooperative launch failed: %s (grid %d)\n", hipGetErrorString(e), grid);
#endif
}
```
